# Optimizing an MI355X kernel written in HIP

```python
import math
import jax, jax.numpy as jnp
from jax import lax
import numpy as np

D_MODEL = 2048
BATCH = 16
SEQ = 256
DEPTH = 2
DEC_BATCH = 4
DEC_SEQ = 1024
PAST_LEN = 512

GRID_W = 64
N_EVEN = (DEPTH + 1) // 2
N_ODD = DEPTH // 2
EPS = 1e-6
ATT_HEADS = 16
ATT_KV_HEADS = 4
ATT_GROUPS = ATT_HEADS // ATT_KV_HEADS
HEAD_DIM = 64
WINDOW = 128
BLOCK = 128
ROPE_BASE = 10000.0
ATT_WIDTH = ATT_HEADS * HEAD_DIM
KV_WIDTH = ATT_KV_HEADS * HEAD_DIM
SGU_GROUPS = 8
SGU_GROUP_DIM = 128
SGU_CHUNK = 128
SGU_WIDTH = SGU_GROUPS * SGU_GROUP_DIM
EVEN_IN = ATT_WIDTH + 2 * KV_WIDTH + 2 * SGU_WIDTH
EVEN_OUT = ATT_WIDTH + SGU_WIDTH
EVEN_SPLITS = (ATT_WIDTH, ATT_WIDTH + KV_WIDTH, ATT_WIDTH + 2 * KV_WIDTH,
               ATT_WIDTH + 2 * KV_WIDTH + SGU_WIDTH)
RET_HEADS = 8
RET_DK = D_MODEL // RET_HEADS
RET_DV = 2 * RET_DK
RET_CHUNK = 128
RET_QK = RET_HEADS * RET_DK
RET_V = RET_HEADS * RET_DV
ODD_IN = 2 * RET_QK + 2 * RET_V
ODD_SPLITS = (RET_QK, 2 * RET_QK, 2 * RET_QK + RET_V)
FF_MULTIPLE = 256
D_FF = -(-8 * D_MODEL // (3 * FF_MULTIPLE)) * FF_MULTIPLE

kernel_name = 'hybrid_window_sgu_retention_diffusion_step'

F32 = jnp.float32


def rmsnorm(x, g):
    xf = x.astype(F32)
    y = xf * lax.rsqrt(jnp.mean(xf * xf, axis=-1, keepdims=True) + EPS)
    return (y * g.astype(F32)).astype(x.dtype)


def adaln(cvec, w, b):
    m = jax.nn.silu(cvec) @ w + b
    return jnp.split(m, 6, axis=-1)


def modulate(h, shift, scale):
    return h * (1 + scale[..., None, :]) + shift[..., None, :]


def axial_rope(L):
    rows = L // GRID_W
    t_row = jnp.repeat(jnp.arange(rows), GRID_W).astype(F32)
    t_col = jnp.tile(jnp.arange(GRID_W), rows).astype(F32)
    n_freq = HEAD_DIM // 4
    inv = ROPE_BASE ** (-jnp.arange(n_freq, dtype=F32) / n_freq)
    ang = jnp.stack([t_row[:, None] * inv, t_col[:, None] * inv], axis=1)
    return jnp.cos(ang), jnp.sin(ang)


def apply_rope(x, cos, sin):
    shp = x.shape
    xr = x.astype(F32).reshape(shp[:-1] + (2, 2, HEAD_DIM // 4))
    x1, x2 = xr[..., 0, :], xr[..., 1, :]
    bshape = (1, shp[1]) + (1,) * (len(shp) - 3) + (2, HEAD_DIM // 4)
    cb, sb = cos.reshape(bshape), sin.reshape(bshape)
    out = jnp.stack([x1 * cb - x2 * sb, x2 * cb + x1 * sb], axis=-2)
    return out.reshape(shp).astype(x.dtype)


def even_project(h, w_in):
    B, L, _ = h.shape
    z = h @ w_in
    q, k, v, u, vg = jnp.split(z, EVEN_SPLITS, axis=-1)
    q = q.reshape(B, L, ATT_KV_HEADS, ATT_GROUPS, HEAD_DIM)
    k = k.reshape(B, L, ATT_KV_HEADS, HEAD_DIM)
    v = v.reshape(B, L, ATT_KV_HEADS, HEAD_DIM)
    return q, k, v, jax.nn.gelu(u), jax.nn.gelu(vg)


def spatial_gating(u, vg, ln_g, ln_b, w_s, b_s):
    B, L, _ = u.shape
    nc = L // SGU_CHUNK
    vf = vg.astype(F32)
    mu = jnp.mean(vf, axis=-1, keepdims=True)
    var = jnp.mean(jnp.square(vf - mu), axis=-1, keepdims=True)
    vn = ((vf - mu) * lax.rsqrt(var + EPS) * ln_g.astype(F32) + ln_b.astype(F32)).astype(u.dtype)
    vc = vn.reshape(B, nc, SGU_CHUNK, SGU_GROUPS, SGU_GROUP_DIM)
    mixed = jnp.einsum('gpq,bnqgc->bnpgc', w_s, vc) + b_s.T[None, None, :, :, None]
    return u * mixed.reshape(B, L, SGU_WIDTH)


def attn_context(q, k, v, sink):
    B, L = q.shape[:2]
    s = jnp.einsum('blkgd,bmkd->bkglm', q, k).astype(F32) * (HEAD_DIM ** -0.5)
    sk = jnp.broadcast_to(sink.astype(F32)[None, :, :, None, None], s.shape[:-1] + (1,))
    p = jax.nn.softmax(jnp.concatenate([sk, s], axis=-1), axis=-1)[..., 1:]
    o = jnp.einsum('bkglm,bmkd->blkgd', p.astype(v.dtype), v)
    return o.reshape(B, L, ATT_WIDTH)


def attn_latent(q, k, v, k_ctx, v_ctx, sink):
    B, L = q.shape[:2]
    nb = L // BLOCK
    qb = q.reshape(B, nb, BLOCK, ATT_KV_HEADS, ATT_GROUPS, HEAD_DIM)
    pad = ((0, 0), (BLOCK, BLOCK), (0, 0), (0, 0))
    kp = jnp.pad(k, pad).reshape(B, nb + 2, BLOCK, ATT_KV_HEADS, HEAD_DIM)
    vp = jnp.pad(v, pad).reshape(B, nb + 2, BLOCK, ATT_KV_HEADS, HEAD_DIM)

    def band(xp):
        return jnp.concatenate([xp[:, :-2], xp[:, 1:-1], xp[:, 2:]], axis=2)

    kb, vb = band(kp), band(vp)
    scale = HEAD_DIM ** -0.5
    s_loc = jnp.einsum('bnqkgd,bnskd->bkgnqs', qb, kb).astype(F32) * scale
    qpos = jnp.arange(nb)[:, None, None] * BLOCK + jnp.arange(BLOCK)[None, :, None]
    kpos = (jnp.arange(nb)[:, None, None] - 1) * BLOCK + jnp.arange(3 * BLOCK)[None, None, :]
    valid = (jnp.abs(qpos - kpos) <= WINDOW) & (kpos >= 0) & (kpos < L)
    s_loc = jnp.where(valid, s_loc, -jnp.inf)
    s_ctx = jnp.einsum('bnqkgd,bmkd->bkgnqm', qb, k_ctx).astype(F32) * scale
    sk = jnp.broadcast_to(sink.astype(F32)[None, :, :, None, None, None], s_loc.shape[:-1] + (1,))
    p = jax.nn.softmax(jnp.concatenate([sk, s_loc, s_ctx], axis=-1), axis=-1)
    p_loc = p[..., 1:1 + 3 * BLOCK].astype(v.dtype)
    p_ctx = p[..., 1 + 3 * BLOCK:].astype(v.dtype)
    o = (jnp.einsum('bkgnqs,bnskd->bnqkgd', p_loc, vb)
         + jnp.einsum('bkgnqm,bmkd->bnqkgd', p_ctx, v_ctx))
    return o.reshape(B, L, ATT_WIDTH)


def even_mixer_context(h, w_in, w_out, sink, ln_g, ln_b, w_s, b_s):
    q, k, v, u, vg = even_project(h, w_in)
    sink_kg = sink.reshape(ATT_KV_HEADS, ATT_GROUPS)
    a = attn_context(q, k, v, sink_kg)
    g = spatial_gating(u, vg, ln_g, ln_b, w_s, b_s)
    return jnp.concatenate([a, g], axis=-1) @ w_out, k, v


def even_mixer_latent(h, k_ctx, v_ctx, cos, sin, w_in, w_out, sink, ln_g, ln_b, w_s, b_s):
    q, k, v, u, vg = even_project(h, w_in)
    q = apply_rope(q, cos, sin)
    k = apply_rope(k, cos, sin)
    sink_kg = sink.reshape(ATT_KV_HEADS, ATT_GROUPS)
    a = attn_latent(q, k, v, k_ctx, v_ctx, sink_kg)
    g = spatial_gating(u, vg, ln_g, ln_b, w_s, b_s)
    return jnp.concatenate([a, g], axis=-1) @ w_out


def retention_scan(q, k, v, log_g, s0):
    B, H, L, _ = q.shape
    C = RET_CHUNK
    nc = L // C
    idx = jnp.arange(C, dtype=F32)
    rel = idx[:, None] - idx[None, :]
    dmask = jnp.exp(jnp.where(rel >= 0, log_g[:, None, None] * rel, -jnp.inf))
    q_in = jnp.exp(log_g[:, None] * (idx + 1))[None, :, :, None]
    k_out = jnp.exp(log_g[:, None] * (C - 1 - idx))[None, :, :, None]
    g_chunk = jnp.exp(log_g * C)[None, :, None, None]

    def chunks(a):
        return jnp.moveaxis(a.reshape(B, H, nc, C, a.shape[-1]), 2, 0)

    def step(S, xs):
        qc, kc, vc = xs
        scores = jnp.einsum('bhid,bhjd->bhij', qc, kc) * dmask
        intra = jnp.einsum('bhij,bhje->bhie', scores, vc)
        inter = jnp.einsum('bhid,bhde->bhie', qc, S) * q_in
        S = S * g_chunk + jnp.einsum('bhjd,bhje->bhde', kc * k_out, vc)
        return S, intra + inter

    S, o = lax.scan(step, s0, (chunks(q), chunks(k), chunks(v)))
    o = jnp.moveaxis(o, 0, 2).reshape(B, H, L, v.shape[-1])
    return o, S


def retention_mixer(h, w_in, w_out, gn_g, dec_f, dec_b, s0_f, s0_b):
    B, L, _ = h.shape
    z = h @ w_in
    q, k, v, g = jnp.split(z, ODD_SPLITS, axis=-1)

    def heads(a, d):
        return a.astype(F32).reshape(B, L, RET_HEADS, d).transpose(0, 2, 1, 3)

    qh = heads(q, RET_DK)
    kh = heads(k, RET_DK) * (RET_DK ** -0.5)
    vh = heads(v, RET_DV)
    lg_f = jax.nn.log_sigmoid(dec_f.astype(F32))
    lg_b = jax.nn.log_sigmoid(dec_b.astype(F32))
    o_f, s_f = retention_scan(qh, kh, vh, lg_f, s0_f.astype(F32))
    flip = lambda a: jnp.flip(a, axis=2)
    o_b, s_b = retention_scan(flip(qh), flip(kh), flip(vh), lg_b, s0_b.astype(F32))
    o = o_f + flip(o_b)
    mu = jnp.mean(o, axis=-1, keepdims=True)
    var = jnp.mean(jnp.square(o - mu), axis=-1, keepdims=True)
    o = ((o - mu) * lax.rsqrt(var + EPS)).transpose(0, 2, 1, 3).reshape(B, L, RET_V)
    o = o * gn_g.astype(F32)
    out = (jax.nn.silu(g.astype(F32)) * o).astype(h.dtype) @ w_out
    return out, s_f.astype(h.dtype), s_b.astype(h.dtype)


def swiglu(h, w_gate, w_up, w_down):
    return (jax.nn.silu(h @ w_gate) * (h @ w_up)) @ w_down


def setup_inputs(seed: int = 0) -> dict:
    key = jax.random.key(seed)
    ks = iter(jax.random.split(key, 40))

    def nrm(shape, scale):
        return jax.random.normal(next(ks), shape, jnp.float32) * scale

    D = D_MODEL
    base = 1.0 - 2.0 ** (-5.0 - np.arange(RET_HEADS))
    decay_logit = jnp.asarray(np.log(base / (1.0 - base)).astype(np.float32))
    return {
        'x_prompt': nrm((BATCH, SEQ, D), 1.0),
        'x_sample': nrm((DEC_BATCH, DEC_SEQ, D), 1.0),
        'cache_attn_k': nrm((DEC_BATCH, N_EVEN, PAST_LEN, ATT_KV_HEADS, HEAD_DIM), 1.0),
        'cache_attn_v': nrm((DEC_BATCH, N_EVEN, PAST_LEN, ATT_KV_HEADS, HEAD_DIM), 1.0),
        'state_ret_fwd': nrm((DEC_BATCH, N_ODD, RET_HEADS, RET_DK, RET_DV), 0.5),
        'state_ret_bwd': nrm((DEC_BATCH, N_ODD, RET_HEADS, RET_DK, RET_DV), 0.5),
        'c': nrm((DEC_BATCH, D), 1.0),
        'c_ctx': nrm((D,), 1.0),
        'ada_w': nrm((DEPTH, D, 6 * D), 0.5 * D ** -0.5),
        'ada_b': nrm((DEPTH, 6 * D), 0.01),
        'norm_mix_g': 1.0 + nrm((DEPTH, D), 0.02),
        'norm_ffn_g': 1.0 + nrm((DEPTH, D), 0.02),
        'even_w_in': nrm((N_EVEN, D, EVEN_IN), D ** -0.5),
        'even_w_out': nrm((N_EVEN, EVEN_OUT, D), EVEN_OUT ** -0.5),
        'attn_sink': nrm((N_EVEN, ATT_HEADS), 0.5),
        'sgu_ln_g': 1.0 + nrm((N_EVEN, SGU_WIDTH), 0.02),
        'sgu_ln_b': nrm((N_EVEN, SGU_WIDTH), 0.01),
        'sgu_w': nrm((N_EVEN, SGU_GROUPS, SGU_CHUNK, SGU_CHUNK), SGU_CHUNK ** -0.5),
        'sgu_b': 1.0 + nrm((N_EVEN, SGU_GROUPS, SGU_CHUNK), 0.01),
        'ret_w_in': nrm((N_ODD, D, ODD_IN), D ** -0.5),
        'ret_w_out': nrm((N_ODD, RET_V, D), RET_V ** -0.5),
        'ret_gn_g': 1.0 + nrm((N_ODD, RET_V), 0.02),
        'ret_decay_fwd': decay_logit[None] + nrm((N_ODD, RET_HEADS), 0.1),
        'ret_decay_bwd': decay_logit[None] + nrm((N_ODD, RET_HEADS), 0.1),
        'ffn_w_gate': nrm((DEPTH, D, D_FF), D ** -0.5),
        'ffn_w_up': nrm((DEPTH, D, D_FF), D ** -0.5),
        'ffn_w_down': nrm((DEPTH, D_FF, D), D_FF ** -0.5),
        'final_g': 1.0 + nrm((D,), 0.02),
    }


def reference(x_prompt, x_sample, cache_attn_k, cache_attn_v, state_ret_fwd, state_ret_bwd,
              c, c_ctx, ada_w, ada_b, norm_mix_g, norm_ffn_g, even_w_in, even_w_out,
              attn_sink, sgu_ln_g, sgu_ln_b, sgu_w, sgu_b, ret_w_in, ret_w_out, ret_gn_g,
              ret_decay_fwd, ret_decay_bwd, ffn_w_gate, ffn_w_up, ffn_w_down, final_g):
    bp = x_prompt.shape[0]
    cos, sin = axial_rope(x_sample.shape[1])
    xp, xs = x_prompt, x_sample
    new_k, new_v, new_sf, new_sb = [], [], [], []
    for i in range(DEPTH):
        j = i // 2
        sh_p, sc_p, ga_p, sh2_p, sc2_p, ga2_p = adaln(c_ctx, ada_w[i], ada_b[i])
        sh_s, sc_s, ga_s, sh2_s, sc2_s, ga2_s = adaln(c, ada_w[i], ada_b[i])
        hp = modulate(rmsnorm(xp, norm_mix_g[i]), sh_p, sc_p)
        hs = modulate(rmsnorm(xs, norm_mix_g[i]), sh_s, sc_s)
        if i % 2 == 0:
            op, kc, vc = even_mixer_context(hp, even_w_in[j], even_w_out[j], attn_sink[j],
                                            sgu_ln_g[j], sgu_ln_b[j], sgu_w[j], sgu_b[j])
            os_ = even_mixer_latent(hs, cache_attn_k[:, j], cache_attn_v[:, j], cos, sin,
                                    even_w_in[j], even_w_out[j], attn_sink[j],
                                    sgu_ln_g[j], sgu_ln_b[j], sgu_w[j], sgu_b[j])
            new_k.append(kc)
            new_v.append(vc)
        else:
            zeros = jnp.zeros((bp, RET_HEADS, RET_DK, RET_DV), F32)
            op, sf, sb = retention_mixer(hp, ret_w_in[j], ret_w_out[j], ret_gn_g[j],
                                         ret_decay_fwd[j], ret_decay_bwd[j], zeros, zeros)
            os_, _, _ = retention_mixer(hs, ret_w_in[j], ret_w_out[j], ret_gn_g[j],
                                        ret_decay_fwd[j], ret_decay_bwd[j],
                                        state_ret_fwd[:, j], state_ret_bwd[:, j])
            new_sf.append(sf)
            new_sb.append(sb)
        xp = xp + ga_p[..., None, :] * op
        xs = xs + ga_s[..., None, :] * os_
        hp = modulate(rmsnorm(xp, norm_ffn_g[i]), sh2_p, sc2_p)
        hs = modulate(rmsnorm(xs, norm_ffn_g[i]), sh2_s, sc2_s)
        xp = xp + ga2_p[..., None, :] * swiglu(hp, ffn_w_gate[i], ffn_w_up[i], ffn_w_down[i])
        xs = xs + ga2_s[..., None, :] * swiglu(hs, ffn_w_gate[i], ffn_w_up[i], ffn_w_down[i])
    y_prompt = rmsnorm(xp, final_g)
    y_sample = rmsnorm(xs, final_g)
    new_attn_k = jnp.stack(new_k, axis=1)
    new_attn_v = jnp.stack(new_v, axis=1)
    new_ret_fwd = jnp.stack(new_sf, axis=1)
    new_ret_bwd = jnp.stack(new_sb, axis=1)
    return (y_prompt, y_sample, new_attn_k, new_attn_v, new_ret_fwd, new_ret_bwd)
```

```cpp
#include <hip/hip_runtime.h>
#include <hip/hip_cooperative_groups.h>
#include <cstdio>
#include <cstring>
#include <cmath>
namespace pg8 {
#define PG8_LAS __attribute__((address_space(3)))
typedef unsigned short bf16_t;
typedef short bf16x8 __attribute__((ext_vector_type(8)));
typedef float f32x4 __attribute__((ext_vector_type(4)));
typedef unsigned u32x4 __attribute__((ext_vector_type(4)));
constexpr int BM = 256, BK = 64, HALF = 128, HTB = HALF * BK * 2  , STAGE_BYTES = 8 * HTB, NXCD = 8, WGM = 8;

__host__ __device__ __forceinline__ int lds_byte(int r, int c) { const int st = (r >> 4) * 2 + (c >> 5), rr = r & 15, cc = c & 31, ob = rr * 64 + cc * 2; return st * 1024 + (ob ^ (((ob >> 9) & 1) << 5)); }
__host__ __device__ __forceinline__ void stage_rc(int b, int& R, int& C) { const int st = b / 1024, sb = b % 1024, swz = sb ^ (((sb >> 9) & 1) << 5); R = (st >> 1) * 16 + swz / 64; C = (st & 1) * 32 + (swz % 64) / 2; }
__host__ __device__ __forceinline__ int perm32(int rho) { const int n = rho >> 4, i = rho & 15; return 8 * (i >> 2) + 4 * n + (i & 3); }

struct Unit { int pm, pn; };
struct Gemm { const bf16_t* A; const bf16_t* Bt; int M, N, K; };

struct StaticOrder {
    int nM, nN, nwg, G, c;
    __host__ __device__ void init(int M, int N, int G_, int c_) { nM = M / BM; nN = N / BM; nwg = nM * nN; G = G_; c = c_; }
    __host__ __device__ bool next(int i, Unit& u) const {
        const long L = (long)i * G + c; if (L >= nwg) return false;
        int wgid = (int)L; { const int q = nwg / NXCD, r = nwg % NXCD, xcd = wgid % NXCD, off = wgid / NXCD; wgid = (xcd < r ? xcd * (q + 1) : r * (q + 1) + (xcd - r) * q) + off; }
        const int nig = WGM * nN, gid = wgid / nig, fm = gid * WGM, gsz = (nM - fm) < WGM ? (nM - fm) : WGM;
        u.pm = fm + ((wgid % nig) % gsz); u.pn = (wgid % nig) / gsz; return true;
    }
    __device__ __forceinline__ void a_ready(const Unit&) const {}
    __device__ __forceinline__ void done(const Unit&) const {}
};
template <class Epi, class Sched, bool STAMP = false>
__device__ __forceinline__ void gemm_phase(PG8_LAS unsigned char* lds, const Gemm g, const Sched& S, const Epi& E, unsigned long long* stamps) {
    const int tid = threadIdx.x, wid = __builtin_amdgcn_readfirstlane(tid >> 6), lane = tid & 63, wr = wid >> 2, wc = wid & 3, fr = lane & 15, fq = lane >> 4;
    const int K = g.K, nt = K / BK;
    int ts_lo = 0, ts_hi = 0, nts = 0; const unsigned long long rt_entry = STAMP ? (unsigned long long)wall_clock64() : 0ull;
#define PG8_STAMP() do { if (STAMP && wid == 0 && nts < 64) { const unsigned long long _c = (unsigned long long)clock64(); \
        ts_lo = (lane == nts) ? (int)(unsigned)_c : ts_lo; ts_hi = (lane == nts) ? (int)(unsigned)(_c >> 32) : ts_hi; ++nts; } } while (0)
    PG8_STAMP();
    unsigned voffA[2], voffB[2];
#pragma unroll
    for (int i = 0; i < 2; ++i) { int R, C; stage_rc(tid * 16 + i * 8192, R, C); const int Rb = Epi::PERM ? ((R & ~31) + perm32(R & 31)) : R;
        voffA[i] = (unsigned)(R * K + C) * 2u; voffB[i] = (unsigned)(Rb * K + C) * 2u; }
    const size_t kstep = (size_t)(BK * 2);
    const size_t hstep = (size_t)HALF * K * 2;
    const size_t tstep = 2 * hstep;
    const unsigned ldsw = (unsigned)wid * 1024u;
    const int aoff = lds_byte(wr * 64 + fr, fq * 8), boff = lds_byte(wc * 32 + fr, fq * 8);
#define PG8_SA(b, h) (((b) * 2 + (h)) * HTB)
#define PG8_SB(b, h) ((4 + (b) * 2 + (h)) * HTB)
#define PG8_STAGE(bufoff, gbase, voff) do { _Pragma("unroll") for (int _i = 0; _i < 2; ++_i) \
        __builtin_amdgcn_global_load_lds((const unsigned*)((const char*)(gbase) + (voff)[_i]), (PG8_LAS unsigned*)(lds + (bufoff) + ldsw + _i * 8192), 16, 0, 0); } while (0)
#define PG8_LDA(dst, b, h) do { _Pragma("unroll") for (int m = 0; m < 4; ++m) _Pragma("unroll") for (int k = 0; k < 2; ++k) dst[m][k] = *(const PG8_LAS bf16x8*)(lds + PG8_SA(b, h) + aoff + m * 2048 + k * 1024); } while (0)
#define PG8_LDB(dst, b, h) do { _Pragma("unroll") for (int n = 0; n < 2; ++n) _Pragma("unroll") for (int k = 0; k < 2; ++k) dst[n][k] = *(const PG8_LAS bf16x8*)(lds + PG8_SB(b, h) + boff + n * 2048 + k * 1024); } while (0)
#define PG8_MMA(ai, bj, At, Bt) do { __builtin_amdgcn_s_setprio(1); _Pragma("unroll") for (int m = 0; m < 4; ++m) _Pragma("unroll") for (int n = 0; n < 2; ++n) _Pragma("unroll") for (int k = 0; k < 2; ++k) \
        acc[ai][bj][m][n] = __builtin_amdgcn_mfma_f32_16x16x32_bf16(Bt[n][k], At[m][k], acc[ai][bj][m][n], 0, 0, 0); __builtin_amdgcn_s_setprio(0); } while (0)
#define PG8_WAIT_V(n) asm volatile("s_waitcnt vmcnt(" #n ")" ::: "memory")
#define PG8_WAIT_L(n) asm volatile("s_waitcnt lgkmcnt(" #n ")" ::: "memory")
#define PG8_BAR __builtin_amdgcn_s_barrier()
#define PG8_SCHED __builtin_amdgcn_sched_barrier(0)
    Unit cur, nxt; int ui = 0;
    if (!S.next(0, cur)) return;
    f32x4 acc[2][2][4][2];
#pragma unroll
    for (int a = 0; a < 2; ++a)
#pragma unroll
        for (int b = 0; b < 2; ++b)
#pragma unroll
            for (int m = 0; m < 4; ++m)
#pragma unroll
                for (int n = 0; n < 2; ++n) acc[a][b][m][n] = (f32x4){0.f, 0.f, 0.f, 0.f};
    bf16x8 At[4][2], B0[2][2], B1[2][2];
    const char* cA = (const char*)g.A + (size_t)cur.pm * tstep; const char* cB = (const char*)g.Bt + (size_t)cur.pn * tstep;
    S.a_ready(cur);
    PG8_STAGE(PG8_SB(0, 0), cB, voffB); PG8_STAGE(PG8_SA(0, 0), cA, voffA); PG8_STAGE(PG8_SB(0, 1), cB + hstep, voffB); PG8_STAGE(PG8_SA(0, 1), cA + hstep, voffA);
    if (wr == 1) PG8_BAR;
    PG8_WAIT_V(4); PG8_BAR;
    PG8_STAGE(PG8_SB(1, 0), cB + kstep, voffB); PG8_STAGE(PG8_SA(1, 0), cA + kstep, voffA); PG8_STAGE(PG8_SB(1, 1), cB + hstep + kstep, voffB);
    PG8_WAIT_V(6); PG8_BAR;
    PG8_STAMP();
    for (;;) {
        const bool has_next = S.next(ui + 1, nxt);
        const char* nA = has_next ? (const char*)g.A + (size_t)nxt.pm * tstep : cA; const char* nB = has_next ? (const char*)g.Bt + (size_t)nxt.pn * tstep : cB;
        for (int t = 0; t < nt; t += 2) {
            const bool last = (t == nt - 2);
            const char* a1 = cA + (size_t)(t + 1) * kstep;
            const char* a2 = last ? nA : cA + (size_t)(t + 2) * kstep; const char* b2 = last ? nB : cB + (size_t)(t + 2) * kstep;
            const char* a3 = a2 + kstep; const char* b3 = b2 + kstep;
            if (last && has_next) S.a_ready(nxt);
            PG8_LDB(B0, 0, 0); PG8_SCHED; PG8_LDA(At, 0, 0); PG8_STAGE(PG8_SA(1, 1), a1 + hstep, voffA);
            PG8_WAIT_L(8); PG8_BAR; PG8_WAIT_L(0); PG8_MMA(0, 0, At, B0); PG8_BAR; PG8_SCHED;
            PG8_LDB(B1, 0, 1); PG8_STAGE(PG8_SB(0, 0), b2, voffB);
            PG8_BAR; PG8_WAIT_L(0); PG8_MMA(0, 1, At, B1); PG8_BAR;
            PG8_LDA(At, 0, 1); PG8_STAGE(PG8_SA(0, 0), a2, voffA);
            PG8_BAR; PG8_WAIT_L(0); PG8_MMA(1, 0, At, B0); PG8_BAR; PG8_SCHED;
            PG8_STAGE(PG8_SB(0, 1), b2 + hstep, voffB);
            PG8_WAIT_V(6); PG8_BAR; PG8_MMA(1, 1, At, B1); PG8_BAR;
            PG8_LDB(B0, 1, 0); PG8_SCHED; PG8_LDA(At, 1, 0); PG8_STAGE(PG8_SA(0, 1), a2 + hstep, voffA);
            PG8_WAIT_L(8); PG8_BAR; PG8_WAIT_L(0); PG8_MMA(0, 0, At, B0); PG8_BAR; PG8_SCHED;
            PG8_LDB(B1, 1, 1); PG8_STAGE(PG8_SB(1, 0), b3, voffB);
            PG8_BAR; PG8_WAIT_L(0); PG8_MMA(0, 1, At, B1); PG8_BAR;
            PG8_LDA(At, 1, 1); PG8_STAGE(PG8_SA(1, 0), a3, voffA);
            PG8_BAR; PG8_WAIT_L(0); PG8_MMA(1, 0, At, B0); PG8_BAR; PG8_SCHED;
            PG8_STAGE(PG8_SB(1, 1), b3 + hstep, voffB);
            PG8_WAIT_V(6); PG8_BAR; PG8_MMA(1, 1, At, B1); PG8_BAR;
        }
        PG8_STAMP();
        if constexpr (!Epi::AFTER_DRAIN) { E(acc, cur, wr, wc, fr, fq); S.done(cur); }
        PG8_STAMP();
        if (!has_next) break;
#pragma unroll
        for (int a = 0; a < 2; ++a)
#pragma unroll
            for (int b = 0; b < 2; ++b)
#pragma unroll
                for (int m = 0; m < 4; ++m)
#pragma unroll
                    for (int n = 0; n < 2; ++n) acc[a][b][m][n] = (f32x4){0.f, 0.f, 0.f, 0.f};
        cur = nxt; cA = nA; cB = nB; ++ui;
    }
    PG8_WAIT_V(0);
    if (wr == 0) PG8_BAR;
    PG8_BAR;
    if constexpr (Epi::AFTER_DRAIN) { E.fused(acc, cur, wr, wc, fr, fq, lds, wid, lane); S.done(cur); }
    PG8_STAMP();
    if (STAMP && wid == 0) { stamps[lane] = lane < nts ? (((unsigned long long)(unsigned)ts_hi << 32) | (unsigned)ts_lo) : 0ull;
        if (lane == 62) stamps[62] = rt_entry; if (lane == 63) stamps[63] = (unsigned long long)wall_clock64(); }
#undef PG8_STAMP
#undef PG8_SA
#undef PG8_SB
#undef PG8_STAGE
#undef PG8_LDA
#undef PG8_LDB
#undef PG8_MMA
#undef PG8_WAIT_V
#undef PG8_WAIT_L
#undef PG8_BAR
#undef PG8_SCHED
}
}


namespace cg = cooperative_groups;
using pg8::bf16_t; using pg8::bf16x8; using pg8::f32x4; using pg8::u32x4; using pg8::Unit;
#define LAS __attribute__((address_space(3)))
typedef short bf16x4 __attribute__((ext_vector_type(4)));
typedef unsigned u32x2 __attribute__((ext_vector_type(2)));

constexpr int NTOK = 8192, DM = 2048, TPR = 4096;
constexpr float EPSN = 1e-6f;
constexpr int MODW = 12288;
constexpr int LDS_BYTES = 131072;

struct Params {
    const float *x_prompt, *x_sample, *cache_k, *cache_v, *st_f, *st_b, *c, *c_ctx, *ada_w, *ada_b, *norm_mix_g, *norm_ffn_g;
    const float *even_w_in, *even_w_out, *attn_sink, *sgu_ln_g, *sgu_ln_b, *sgu_w, *sgu_b, *ret_w_in, *ret_w_out, *ret_gn_g, *ret_dec_f, *ret_dec_b;
    const float *ffn_w_gate, *ffn_w_up, *ffn_w_down, *final_g;
    float* out;
    bf16_t *wt_in0, *wt_out0, *wt_f1a, *wt_f1b, *wt_f2a, *wt_f2b, *wt_in1, *wt_out1;
    float* mod;
    bf16_t* h;
    bf16_t *q0, *k0, *vt0, *u0, *vg0, *ck, *cvt, *ag;
    float *xa, *xb;
    bf16_t* act;
    bf16_t *q1, *k1, *sg1, *kt1, *vt1, *o1, *a2;
};
typedef const Params __attribute__((address_space(4))) * ParamsCP;


__device__ __forceinline__ unsigned pk2(float lo, float hi) { unsigned r; asm("v_cvt_pk_bf16_f32 %0, %1, %2" : "=v"(r) : "v"(lo), "v"(hi)); return r; }
__device__ __forceinline__ bf16_t f2bf(float f) { return (bf16_t)(pk2(f, 0.f) & 0xffffu); }
__device__ __forceinline__ float bflo(unsigned w) { return __uint_as_float(w << 16); }
__device__ __forceinline__ float bfhi(unsigned w) { return __uint_as_float(w & 0xffff0000u); }
__device__ __forceinline__ u32x2 pack4(f32x4 a) { u32x2 w; w.x = pk2(a[0], a[1]); w.y = pk2(a[2], a[3]); return w; }
__device__ __forceinline__ u32x4 pack8u(f32x4 a, f32x4 b) { u32x4 w; w.x = pk2(a[0], a[1]); w.y = pk2(a[2], a[3]); w.z = pk2(b[0], b[1]); w.w = pk2(b[2], b[3]); return w; }
__device__ __forceinline__ bf16x8 pack8(f32x4 a, f32x4 b) { return __builtin_bit_cast(bf16x8, pack8u(a, b)); }
__device__ __forceinline__ f32x4 unpack4(u32x2 w) { f32x4 r; r[0] = bflo(w.x); r[1] = bfhi(w.x); r[2] = bflo(w.y); r[3] = bfhi(w.y); return r; }
__device__ __forceinline__ bf16x8 cat44(bf16x4 a, bf16x4 b) { return __builtin_shufflevector(a, b, 0, 1, 2, 3, 4, 5, 6, 7); }
__device__ __forceinline__ f32x4 mfma16(bf16x8 a, bf16x8 b, f32x4 c) { return __builtin_amdgcn_mfma_f32_16x16x32_bf16(a, b, c, 0, 0, 0); }
__device__ __forceinline__ float siluf(float v) { return v / (1.0f + __expf(-v)); }
__device__ __forceinline__ float gelu_tanh(float v) { const float y = 0.7978845608028654f * (v + 0.044715f * v * v * v); return v / (1.0f + __expf(-2.0f * y)); }
__device__ __forceinline__ float wave_sum(float v) {
#pragma unroll
    for (int o = 32; o >= 1; o >>= 1) v += __shfl_xor(v, o);
    return v;
}

struct EpiInProj0 {
    static constexpr bool PERM = false, AFTER_DRAIN = false;
    bf16_t *q, *k, *vt, *u, *vg; float *outk, *outv;
    __device__ __forceinline__ void operator()(const f32x4 (&acc)[2][2][4][2], const Unit& un, int wr_, int wc_, int fr_, int fq_) const {
        int wr = wr_, wc = wc_, fr = fr_, fq = fq_; asm volatile("" : "+s"(wr), "+s"(wc), "+v"(fr), "+v"(fq));
        const int pn = un.pn;
        const int row0 = un.pm * 256 + wr * 64 + fr;
        const int cb = wc * 32 + 4 * fq;
        if (pn < 5) {
            const bool isq = pn < 4;
            const bool rope = un.pm >= 16;
            float inv[4];
#pragma unroll
            for (int j = 0; j < 4; ++j) inv[j] = __builtin_amdgcn_exp2f(-(float)(4 * fq + j) * 0.8304820237218406f);
#pragma unroll
            for (int ai = 0; ai < 2; ++ai)
#pragma unroll
                for (int m = 0; m < 4; ++m) {
                    const int row = row0 + ai * 128 + m * 16;
                    float cs[4], sn[4];
                    if (rope) {
                        const int pos = (row - TPR) & 1023;
                        const float t = (wc & 1) ? (float)(pos & 63) : (float)(pos >> 6);
#pragma unroll
                        for (int j = 0; j < 4; ++j) { const float a = t * inv[j]; cs[j] = __cosf(a); sn[j] = __sinf(a); }
                    } else {
#pragma unroll
                        for (int j = 0; j < 4; ++j) { cs[j] = 1.f; sn[j] = 0.f; }
                    }
#pragma unroll
                    for (int bj = 0; bj < 2; ++bj) {
                        const f32x4 x1 = acc[ai][bj][m][0], x2 = acc[ai][bj][m][1];
                        f32x4 o1, o2;
#pragma unroll
                        for (int j = 0; j < 4; ++j) { o1[j] = x1[j] * cs[j] - x2[j] * sn[j]; o2[j] = x2[j] * cs[j] + x1[j] * sn[j]; }
                        const int c = bj * 128 + cb;
                        if (isq) {
                            bf16_t* d = q + (size_t)row * 1024 + pn * 256 + c;
                            *(u32x2*)d = pack4(o1); *(u32x2*)(d + 16) = pack4(o2);
                        } else {
                            bf16_t* d = k + (size_t)row * 256 + c;
                            *(u32x2*)d = pack4(o1); *(u32x2*)(d + 16) = pack4(o2);
                            if (!rope) { float* ok = outk + (size_t)row * 256 + c; *(f32x4*)ok = x1; *(f32x4*)(ok + 16) = x2; }
                        }
                    }
                    __builtin_amdgcn_sched_barrier(0);
                }
        } else if (pn == 5) {
            const bool prm = un.pm < 16;
#pragma unroll
            for (int ai = 0; ai < 2; ++ai)
#pragma unroll
                for (int m = 0; m < 4; ++m) {
                    const int row = row0 + ai * 128 + m * 16;
#pragma unroll
                    for (int bj = 0; bj < 2; ++bj)
#pragma unroll
                        for (int n = 0; n < 2; ++n) {
                            const f32x4 v = acc[ai][bj][m][n];
                            const int c = bj * 128 + cb + n * 16;
                            if (prm) *(f32x4*)(outv + (size_t)row * 256 + c) = v;
#pragma unroll
                            for (int j = 0; j < 4; ++j) vt[(size_t)(c + j) * NTOK + row] = f2bf(v[j]);
                            __builtin_amdgcn_sched_barrier(0);
                        }
                }
        } else {
            bf16_t* dst = pn < 10 ? u + (pn - 6) * 256 : vg + (pn - 10) * 256;
#pragma unroll
            for (int ai = 0; ai < 2; ++ai)
#pragma unroll
                for (int m = 0; m < 4; ++m) {
                    const int row = row0 + ai * 128 + m * 16;
#pragma unroll
                    for (int bj = 0; bj < 2; ++bj)
#pragma unroll
                        for (int n = 0; n < 2; ++n) {
                            const f32x4 v = acc[ai][bj][m][n];
                            f32x4 o;
#pragma unroll
                            for (int j = 0; j < 4; ++j) o[j] = gelu_tanh(v[j]);
                            *(u32x2*)(dst + (size_t)row * 1024 + bj * 128 + cb + n * 16) = pack4(o);
                            __builtin_amdgcn_sched_barrier(0);
                        }
                }
        }
    }
};

struct EpiResid {
    static constexpr bool PERM = false, AFTER_DRAIN = false;
    const float *res_lo, *res_hi; const float* gate; float* out;
    __device__ __forceinline__ void operator()(const f32x4 (&acc)[2][2][4][2], const Unit& un, int wr_, int wc_, int fr_, int fq_) const {
        int wr = wr_, wc = wc_, fr = fr_, fq = fq_; asm volatile("" : "+s"(wr), "+s"(wc), "+v"(fr), "+v"(fq));
        const int cond = un.pm < 16 ? 0 : 1 + ((un.pm - 16) >> 2);
        const int row0 = un.pm * 256 + wr * 64 + fr, col0 = un.pn * 256 + wc * 32 + 4 * fq;
        const float* resb = un.pm < 16 ? res_lo : res_hi;
        f32x4 gv[2][2];
#pragma unroll
        for (int bj = 0; bj < 2; ++bj)
#pragma unroll
            for (int n = 0; n < 2; ++n) gv[bj][n] = *(const f32x4*)(gate + (size_t)cond * MODW + col0 + bj * 128 + n * 16);
#pragma unroll
        for (int ai = 0; ai < 2; ++ai)
#pragma unroll
            for (int m = 0; m < 4; ++m) {
                const size_t ro = (size_t)(row0 + ai * 128 + m * 16) * DM + col0;
#pragma unroll
                for (int bj = 0; bj < 2; ++bj)
#pragma unroll
                    for (int n = 0; n < 2; ++n) {
                        const f32x4 r = *(const f32x4*)(resb + ro + bj * 128 + n * 16);
                        *(f32x4*)(out + ro + bj * 128 + n * 16) = r + gv[bj][n] * acc[ai][bj][m][n];
                    }
            }
    }
};

struct EpiSwiGLU {
    static constexpr bool PERM = true, AFTER_DRAIN = false;
    bf16_t* act;
    __device__ __forceinline__ void operator()(const f32x4 (&acc)[2][2][4][2], const Unit& un, int wr_, int wc_, int fr_, int fq_) const {
        int wr = wr_, wc = wc_, fr = fr_, fq = fq_; asm volatile("" : "+s"(wr), "+s"(wc), "+v"(fr), "+v"(fq));
        const int row0 = un.pm * 256 + wr * 64 + fr, col0 = un.pn * 128 + wc * 32 + 8 * fq;
#pragma unroll
        for (int ai = 0; ai < 2; ++ai)
#pragma unroll
            for (int m = 0; m < 4; ++m) {
                f32x4 o[2];
#pragma unroll
                for (int n = 0; n < 2; ++n)
#pragma unroll
                    for (int j = 0; j < 4; ++j) o[n][j] = siluf(acc[ai][0][m][n][j]) * acc[ai][1][m][n][j];
                *(u32x4*)(act + (size_t)(row0 + ai * 128 + m * 16) * 5632 + col0) = pack8u(o[0], o[1]);
            }
    }
};

struct EpiRetIn {
    static constexpr bool PERM = true, AFTER_DRAIN = false;
    bf16_t *q1, *k1, *sg1, *kt1, *vt1;
    __device__ __forceinline__ void operator()(const f32x4 (&acc)[2][2][4][2], const Unit& un, int wr_, int wc_, int fr_, int fq_) const {
        int wr = wr_, wc = wc_, fr = fr_, fq = fq_; asm volatile("" : "+s"(wr), "+s"(wc), "+v"(fr), "+v"(fq));
        const int pn = un.pn;
        const int row0 = un.pm * 256 + wr * 64 + fr, cb = wc * 32 + 8 * fq;
#pragma unroll
        for (int ai = 0; ai < 2; ++ai)
#pragma unroll
            for (int m = 0; m < 4; ++m) {
                const int row = row0 + ai * 128 + m * 16;
#pragma unroll
                for (int bj = 0; bj < 2; ++bj) {
                    f32x4 v0 = acc[ai][bj][m][0], v1 = acc[ai][bj][m][1];
                    const int c = bj * 128 + cb;
                    if (pn < 8) {
                        *(u32x4*)(q1 + (size_t)row * 2048 + pn * 256 + c) = pack8u(v0, v1);
                    } else if (pn < 16) {
                        v0 *= 0.0625f; v1 *= 0.0625f;
                        const int cc = (pn - 8) * 256 + c;
                        *(u32x4*)(k1 + (size_t)row * 2048 + cc) = pack8u(v0, v1);
#pragma unroll
                        for (int j = 0; j < 4; ++j) { kt1[(size_t)(cc + j) * NTOK + row] = f2bf(v0[j]); kt1[(size_t)(cc + 4 + j) * NTOK + row] = f2bf(v1[j]); }
                    } else if (pn < 32) {
                        const int cc = (pn - 16) * 256 + c;
#pragma unroll
                        for (int j = 0; j < 4; ++j) { vt1[(size_t)(cc + j) * NTOK + row] = f2bf(v0[j]); vt1[(size_t)(cc + 4 + j) * NTOK + row] = f2bf(v1[j]); }
                    } else {
                        f32x4 s0, s1;
#pragma unroll
                        for (int j = 0; j < 4; ++j) { s0[j] = siluf(v0[j]); s1[j] = siluf(v1[j]); }
                        *(u32x4*)(sg1 + (size_t)row * 4096 + (pn - 32) * 256 + c) = pack8u(s0, s1);
                    }
                    __builtin_amdgcn_sched_barrier(0);
                }
            }
    }
};

template <class Epi>
__device__ __forceinline__ void run_gemm(LAS unsigned char* lds, const bf16_t* A, const bf16_t* Bt, int N, int K, const Epi& E) {
    pg8::Gemm g; g.A = A; g.Bt = Bt; g.M = NTOK; g.N = N; g.K = K;
    pg8::StaticOrder S; S.init(NTOK, N, (int)gridDim.x, (int)blockIdx.x);
    pg8::gemm_phase<Epi, pg8::StaticOrder, false>(lds, g, S, E, nullptr);
}

template <int MODE>
__device__ __forceinline__ void cvt_wt(const float* __restrict__ s0, const float* __restrict__ s1, int ld, bf16_t* __restrict__ dst, int K, int nrows, int tid) {
    const int nkb = K >> 5, nit = nkb * (nrows >> 9);
    for (int it = blockIdx.x; it < nit; it += gridDim.x) {
        const int kb = it % nkb, rb = it / nkb;
        const int r = rb * 512 + tid;
        const float* src; int col;
        if (MODE == 0) { src = s0; col = r; } else { src = ((r >> 7) & 1) ? s1 : s0; col = (r >> 8) * 128 + (r & 127); }
        const float* sp = src + (size_t)(kb * 32) * ld + col;
        float v[32];
#pragma unroll
        for (int i = 0; i < 32; ++i) v[i] = sp[(size_t)i * ld];
        u32x4* dp = (u32x4*)(dst + (size_t)r * K + kb * 32);
#pragma unroll
        for (int i = 0; i < 4; ++i) { u32x4 w; w.x = pk2(v[8 * i], v[8 * i + 1]); w.y = pk2(v[8 * i + 2], v[8 * i + 3]); w.z = pk2(v[8 * i + 4], v[8 * i + 5]); w.w = pk2(v[8 * i + 6], v[8 * i + 7]); dp[i] = w; }
    }
}

__device__ __forceinline__ void phase0(ParamsCP p, LAS unsigned char* lds, int tid) {
    LAS float* sc = (LAS float*)lds;
    for (int i = tid; i < 5 * 2048; i += 512) { const int cnd = i >> 11, k = i & 2047; const float v = cnd == 0 ? p->c_ctx[k] : p->c[(cnd - 1) * 2048 + k]; sc[i] = siluf(v); }
    __syncthreads();
    for (int it = blockIdx.x; it < 2 * 24 * 16; it += gridDim.x) {
        const int kb = it & 15, nb = (it >> 4) % 24, li = it / (16 * 24);
        const int n = nb * 512 + tid;
        const float* w = p->ada_w + ((size_t)li * 2048 + kb * 128) * MODW + n;
        float a0 = 0.f, a1 = 0.f, a2 = 0.f, a3 = 0.f, a4 = 0.f;
#pragma unroll 4
        for (int k = 0; k < 128; k += 4) {
            const float w0 = w[(size_t)k * MODW], w1 = w[(size_t)(k + 1) * MODW], w2 = w[(size_t)(k + 2) * MODW], w3 = w[(size_t)(k + 3) * MODW];
            const int kk = kb * 128 + k;
            const f32x4 s0 = *(const LAS f32x4*)(sc + kk), s1 = *(const LAS f32x4*)(sc + 2048 + kk), s2 = *(const LAS f32x4*)(sc + 4096 + kk), s3 = *(const LAS f32x4*)(sc + 6144 + kk), s4 = *(const LAS f32x4*)(sc + 8192 + kk);
            a0 += s0[0] * w0 + s0[1] * w1 + s0[2] * w2 + s0[3] * w3;
            a1 += s1[0] * w0 + s1[1] * w1 + s1[2] * w2 + s1[3] * w3;
            a2 += s2[0] * w0 + s2[1] * w1 + s2[2] * w2 + s2[3] * w3;
            a3 += s3[0] * w0 + s3[1] * w1 + s3[2] * w2 + s3[3] * w3;
            a4 += s4[0] * w0 + s4[1] * w1 + s4[2] * w2 + s4[3] * w3;
        }
        if (kb == 0) { const float b = p->ada_b[li * MODW + n]; a0 += b; a1 += b; a2 += b; a3 += b; a4 += b; }
        float* m = p->mod + (size_t)li * 5 * MODW + n;
        unsafeAtomicAdd(m, a0); unsafeAtomicAdd(m + MODW, a1); unsafeAtomicAdd(m + 2 * MODW, a2); unsafeAtomicAdd(m + 3 * MODW, a3); unsafeAtomicAdd(m + 4 * MODW, a4);
    }
    for (int i = blockIdx.x * 512 + tid; i < 4 * 512 * 256 / 8; i += gridDim.x * 512) {
        const float* s = p->cache_k + (size_t)i * 8; const f32x4 a = *(const f32x4*)s, b = *(const f32x4*)(s + 4);
        *(u32x4*)(p->ck + (size_t)i * 8) = pack8u(a, b);
    }
    for (int i = blockIdx.x * 512 + tid; i < 4 * 64 * 256; i += gridDim.x * 512) {
        const int c = i & 255, mb = (i >> 8) & 63, b = i >> 14;
        float v[8];
#pragma unroll
        for (int j = 0; j < 8; ++j) v[j] = p->cache_v[((size_t)(b * 512 + mb * 8 + j)) * 256 + c];
        u32x4 w; w.x = pk2(v[0], v[1]); w.y = pk2(v[2], v[3]); w.z = pk2(v[4], v[5]); w.w = pk2(v[6], v[7]);
        *(u32x4*)(p->cvt + ((size_t)(b * 256 + c)) * 512 + mb * 8) = w;
    }
    cvt_wt<0>(p->even_w_in, nullptr, 3584, p->wt_in0, 2048, 3584, tid);
    cvt_wt<0>(p->even_w_out, nullptr, 2048, p->wt_out0, 2048, 2048, tid);
    cvt_wt<1>(p->ffn_w_gate, p->ffn_w_up, 5632, p->wt_f1a, 2048, 11264, tid);
    cvt_wt<0>(p->ffn_w_down, nullptr, 2048, p->wt_f2a, 5632, 2048, tid);
    cvt_wt<0>(p->ret_w_in, nullptr, 12288, p->wt_in1, 2048, 12288, tid);
    cvt_wt<0>(p->ret_w_out, nullptr, 2048, p->wt_out1, 4096, 2048, tid);
    cvt_wt<1>(p->ffn_w_gate + (size_t)2048 * 5632, p->ffn_w_up + (size_t)2048 * 5632, 5632, p->wt_f1b, 2048, 11264, tid);
    cvt_wt<0>(p->ffn_w_down + (size_t)5632 * 2048, nullptr, 2048, p->wt_f2b, 5632, 2048, tid);
}

__device__ __forceinline__ void norm_phase(const float* xlo, const float* xhi, const float* g, const float* shift, const float* scale, bf16_t* h, int wid, int lane) {
    for (int row = blockIdx.x * 8 + wid; row < NTOK; row += gridDim.x * 8) {
        const float* xr = (row < TPR ? xlo : xhi) + (size_t)row * DM;
        const int cond = row < TPR ? 0 : 1 + ((row - TPR) >> 10);
        f32x4 v[8]; float ss = 0.f;
#pragma unroll
        for (int i = 0; i < 8; ++i) { v[i] = *(const f32x4*)(xr + i * 256 + lane * 4); ss += v[i][0] * v[i][0] + v[i][1] * v[i][1] + v[i][2] * v[i][2] + v[i][3] * v[i][3]; }
        ss = wave_sum(ss);
        const float rstd = rsqrtf(ss * (1.0f / DM) + EPSN);
#pragma unroll
        for (int i = 0; i < 8; ++i) {
            const int c = i * 256 + lane * 4;
            const f32x4 gg = *(const f32x4*)(g + c), sh = *(const f32x4*)(shift + (size_t)cond * MODW + c), sc = *(const f32x4*)(scale + (size_t)cond * MODW + c);
            const f32x4 o = v[i] * rstd * gg * (1.0f + sc) + sh;
            *(u32x2*)(h + (size_t)row * DM + c) = pack4(o);
        }
    }
}
__device__ __forceinline__ void final_norm_phase(const float* x, const float* g, float* out, int wid, int lane) {
    for (int row = blockIdx.x * 8 + wid; row < NTOK; row += gridDim.x * 8) {
        const float* xr = x + (size_t)row * DM;
        f32x4 v[8]; float ss = 0.f;
#pragma unroll
        for (int i = 0; i < 8; ++i) { v[i] = *(const f32x4*)(xr + i * 256 + lane * 4); ss += v[i][0] * v[i][0] + v[i][1] * v[i][1] + v[i][2] * v[i][2] + v[i][3] * v[i][3]; }
        ss = wave_sum(ss);
        const float rstd = rsqrtf(ss * (1.0f / DM) + EPSN);
#pragma unroll
        for (int i = 0; i < 8; ++i) { const int c = i * 256 + lane * 4; *(f32x4*)(out + (size_t)row * DM + c) = v[i] * rstd * *(const f32x4*)(g + c); }
    }
}

__device__ __forceinline__ void sgu_phase(ParamsCP p, LAS unsigned char* lds, int tid, int wid, int lane) {
    LAS float* stat = (LAS float*)lds;
    LAS bf16_t* vnT = (LAS bf16_t*)(lds + 1024);
    const int er = lane & 15, g4 = lane >> 4;
    for (int it = blockIdx.x; it < 512; it += gridDim.x) {
        const int chunk = it >> 3, g = it & 7, tok0 = chunk * 128;
        __syncthreads();
        for (int r = 0; r < 16; ++r) {
            const bf16_t* vp = p->vg0 + (size_t)(tok0 + 16 * wid + r) * 1024 + lane * 16;
            const u32x4 a = *(const u32x4*)vp, b = *(const u32x4*)(vp + 8);
            float s = 0.f, ss = 0.f;
#pragma unroll
            for (int i = 0; i < 4; ++i) { const float x0 = bflo(a[i]), x1 = bfhi(a[i]), x2 = bflo(b[i]), x3 = bfhi(b[i]); s += (x0 + x1) + (x2 + x3); ss += (x0 * x0 + x1 * x1) + (x2 * x2 + x3 * x3); }
            s = wave_sum(s); ss = wave_sum(ss);
            const float mu = s * (1.0f / 1024.0f), var = ss * (1.0f / 1024.0f) - mu * mu;
            if (lane == 0) { stat[2 * (16 * wid + r)] = mu; stat[2 * (16 * wid + r) + 1] = rsqrtf(var + EPSN); }
        }
        __syncthreads();
#pragma unroll
        for (int i2 = 0; i2 < 4; ++i2) {
            const int idx = tid + 512 * i2, q = idx >> 4, c8 = (idx & 15) * 8;
            const u32x4 raw = *(const u32x4*)(p->vg0 + (size_t)(tok0 + q) * 1024 + g * 128 + c8);
            const float mu = stat[2 * q], rs = stat[2 * q + 1];
            const f32x4 g0 = *(const f32x4*)(p->sgu_ln_g + g * 128 + c8), g1 = *(const f32x4*)(p->sgu_ln_g + g * 128 + c8 + 4);
            const f32x4 b0 = *(const f32x4*)(p->sgu_ln_b + g * 128 + c8), b1 = *(const f32x4*)(p->sgu_ln_b + g * 128 + c8 + 4);
#pragma unroll
            for (int i = 0; i < 4; ++i) {
                const float x0 = (bflo(raw[i]) - mu) * rs, x1 = (bfhi(raw[i]) - mu) * rs;
                const float gg0 = (2 * i < 4) ? g0[(2 * i) & 3] : g1[(2 * i) & 3], gg1 = (2 * i + 1 < 4) ? g0[(2 * i + 1) & 3] : g1[(2 * i + 1) & 3];
                const float bb0 = (2 * i < 4) ? b0[(2 * i) & 3] : b1[(2 * i) & 3], bb1 = (2 * i + 1 < 4) ? b0[(2 * i + 1) & 3] : b1[(2 * i + 1) & 3];
                vnT[(c8 + 2 * i) * 136 + q] = f2bf(x0 * gg0 + bb0);
                vnT[(c8 + 2 * i + 1) * 136 + q] = f2bf(x1 * gg1 + bb1);
            }
        }
        __syncthreads();
        bf16x8 wf[4];
#pragma unroll
        for (int kk = 0; kk < 4; ++kk) { const float* wp = p->sgu_w + ((size_t)(g * 128 + 16 * wid + er)) * 128 + 32 * kk + g4 * 8; wf[kk] = pack8(*(const f32x4*)wp, *(const f32x4*)(wp + 4)); }
        const int tok = tok0 + 16 * wid + er; const float bs = p->sgu_b[g * 128 + 16 * wid + er];
#pragma unroll
        for (int cc = 0; cc < 8; ++cc) {
            f32x4 a = {0.f, 0.f, 0.f, 0.f};
#pragma unroll
            for (int kk = 0; kk < 4; ++kk) { const bf16x8 af = *(const LAS bf16x8*)(vnT + (16 * cc + er) * 136 + 32 * kk + g4 * 8); a = mfma16(af, wf[kk], a); }
            const int c = g * 128 + 16 * cc + g4 * 4;
            const f32x4 uf = unpack4(*(const u32x2*)(p->u0 + (size_t)tok * 1024 + c));
            *(u32x2*)(p->ag + (size_t)tok * 2048 + 1024 + c) = pack4(uf * (a + bs));
        }
    }
}

__device__ __forceinline__ void attn_phase(ParamsCP p, int wid, int lane) {
    const int er = lane & 15, g4 = lane >> 4;
    const float SC = 0.125f * 1.4426950408889634f;
    for (int it = blockIdx.x * 8 + wid; it < 8192; it += gridDim.x * 8) {
        const bool latent = it < 4096;
        int b, h, qt;
        if (latent) { qt = it & 63; h = (it >> 6) & 15; b = it >> 10; } else { const int j = it - 4096; qt = j & 15; h = (j >> 4) & 15; b = j >> 8; }
        const int tokbase = latent ? TPR + b * 1024 : b * 256;
        const int L = latent ? 1024 : 256;
        const int q0 = qt * 16, kvh = h >> 2;
        const bf16_t* qp = p->q0 + (size_t)(tokbase + q0 + er) * 1024 + h * 64 + g4 * 8;
        const bf16x8 qf0 = *(const bf16x8*)qp, qf1 = *(const bf16x8*)(qp + 32);
        float m = p->attn_sink[h] * 1.4426950408889634f;
        float l = g4 == 0 ? 1.0f : 0.0f;
        f32x4 o[4];
#pragma unroll
        for (int dd = 0; dd < 4; ++dd) o[dd] = (f32x4){0.f, 0.f, 0.f, 0.f};
        const int qpos = q0 + er;
        int klo = 0, khi = L;
        if (latent) { klo = (q0 - 128 < 0 ? 0 : q0 - 128) & ~31; khi = (q0 + 16 + 128 + 31) & ~31; if (khi > L) khi = L; }
        const int nloc = (khi - klo) >> 5, ntl = nloc + (latent ? 16 : 0);
        for (int ti = 0; ti < ntl; ++ti) {
            const bool loc = ti < nloc;
            const int kt = loc ? klo + ti * 32 : (ti - nloc) * 32;
            const bf16_t* kbase = loc ? p->k0 + (size_t)(tokbase + kt) * 256 : p->ck + (size_t)(b * 512 + kt) * 256;
            const bf16_t* vbase = loc ? p->vt0 + (size_t)(kvh * 64) * NTOK + tokbase + kt : p->cvt + (size_t)(b * 256 + kvh * 64) * 512 + kt;
            const int vstride = loc ? NTOK : 512;
            const bool mask = loc && latent;
            f32x4 s[2];
#pragma unroll
            for (int t = 0; t < 2; ++t) {
                const bf16_t* kp = kbase + (size_t)(16 * t + er) * 256 + kvh * 64 + g4 * 8;
                const bf16x8 kf0 = *(const bf16x8*)kp, kf1 = *(const bf16x8*)(kp + 32);
                s[t] = mfma16(kf0, qf0, (f32x4){0.f, 0.f, 0.f, 0.f});
                s[t] = mfma16(kf1, qf1, s[t]);
            }
            bf16x8 vf[4];
#pragma unroll
            for (int dd = 0; dd < 4; ++dd) { const bf16_t* vp = vbase + (size_t)(16 * dd + er) * vstride + g4 * 4; vf[dd] = cat44(*(const bf16x4*)vp, *(const bf16x4*)(vp + 16)); }
            float mx = -INFINITY;
#pragma unroll
            for (int t = 0; t < 2; ++t)
#pragma unroll
                for (int j = 0; j < 4; ++j) {
                    float v = s[t][j] * SC;
                    if (mask) { const int kpos = kt + 16 * t + g4 * 4 + j; const int d = qpos - kpos; if (d > 128 || d < -128) v = -INFINITY; }
                    s[t][j] = v; mx = fmaxf(mx, v);
                }
            mx = fmaxf(mx, __shfl_xor(mx, 16)); mx = fmaxf(mx, __shfl_xor(mx, 32));
            const float mnew = fmaxf(m, mx);
            const float alpha = __builtin_amdgcn_exp2f(m - mnew);
            m = mnew; l *= alpha;
#pragma unroll
            for (int dd = 0; dd < 4; ++dd) o[dd] *= alpha;
            f32x4 p0, p1;
#pragma unroll
            for (int j = 0; j < 4; ++j) { p0[j] = __builtin_amdgcn_exp2f(s[0][j] - mnew); p1[j] = __builtin_amdgcn_exp2f(s[1][j] - mnew); l += p0[j] + p1[j]; }
            const bf16x8 pf = pack8(p0, p1);
#pragma unroll
            for (int dd = 0; dd < 4; ++dd) o[dd] = mfma16(vf[dd], pf, o[dd]);
        }
        l += __shfl_xor(l, 16); l += __shfl_xor(l, 32);
        const float rl = 1.0f / l;
        bf16_t* op = p->ag + (size_t)(tokbase + q0 + er) * 2048 + h * 64 + g4 * 4;
#pragma unroll
        for (int dd = 0; dd < 4; ++dd) *(u32x2*)(op + 16 * dd) = pack4(o[dd] * rl);
    }
}

__device__ __forceinline__ float logsig(float x) { return -log1pf(__expf(-x)); }
__device__ __forceinline__ bf16x8 scale8(bf16x8 f, const float (&s)[8]) {
    const u32x4 w = __builtin_bit_cast(u32x4, f); u32x4 r;
#pragma unroll
    for (int i = 0; i < 4; ++i) r[i] = pk2(bflo(w[i]) * s[2 * i], bfhi(w[i]) * s[2 * i + 1]);
    return __builtin_bit_cast(bf16x8, r);
}

__device__ __forceinline__ void ret_item(ParamsCP p, LAS unsigned char* lds, int seq, int h, int es, int tid, int wid, int lane) {
    LAS bf16_t* Qs = (LAS bf16_t*)lds; LAS bf16_t* Ks = Qs + 64 * 264; LAS bf16_t* KTs = Ks + 64 * 264; LAS bf16_t* Ps = KTs + 256 * 72;
    const bool sample = seq < 4;
    const int tokbase = sample ? TPR + seq * 1024 : (seq - 4) * 256;
    const int NC = sample ? 16 : 4;
    const int er_ = lane & 15, g4_ = lane >> 4;
    const int e0 = h * 512 + es * 128 + wid * 16;
    const float lgf = logsig(p->ret_dec_f[h]), lgb = logsig(p->ret_dec_b[h]);
    f32x4 S[16];
#pragma unroll 1
    for (int dir = 0; dir < 2; ++dir) {
        const float lg = dir ? lgf : lgb;
        if (sample) {
            const float* st = (dir ? p->st_f : p->st_b) + ((size_t)(seq * 8 + h) * 256) * 512 + es * 128 + wid * 16 + er_;
#pragma unroll
            for (int t = 0; t < 16; ++t)
#pragma unroll
                for (int j = 0; j < 4; ++j) { S[t][j] = st[(size_t)(16 * t + g4_ * 4 + j) * 512]; if (j == 3) __builtin_amdgcn_sched_barrier(0); }
        } else {
#pragma unroll
            for (int t = 0; t < 16; ++t) S[t] = (f32x4){0.f, 0.f, 0.f, 0.f};
        }
        const float gch = __expf(lg * 64.0f);
#pragma unroll 1
        for (int s = 0; s < NC; ++s) {
            const int cc = dir ? s : NC - 1 - s, tok0 = tokbase + cc * 64;
            int tidv = tid, er = er_, g4 = g4_; asm volatile("" : "+v"(tidv), "+v"(er), "+v"(g4));
            const bf16_t* qb = p->q1 + (size_t)tok0 * 2048 + h * 256;
            const bf16_t* kb = p->k1 + (size_t)tok0 * 2048 + h * 256;
            const bf16_t* ktb = p->kt1 + (size_t)(h * 256) * NTOK + tok0;
            const bf16_t* vtb = p->vt1 + (size_t)e0 * NTOK + tok0;
            bf16_t* ob = p->o1 + (size_t)tok0 * 4096 + e0;
            __syncthreads();
#pragma unroll
            for (int i2 = 0; i2 < 4; ++i2) {
                const int idx = tidv + 512 * i2;
                { const int r = idx >> 5, c8 = (idx & 31) * 8;
                  *(LAS u32x4*)(Qs + r * 264 + c8) = *(const u32x4*)(qb + (unsigned)(r * 2048 + c8));
                  if (dir) *(LAS u32x4*)(Ks + r * 264 + c8) = *(const u32x4*)(kb + (unsigned)(r * 2048 + c8)); }
                { const int r = idx >> 3, c8 = (idx & 7) * 8;
                  *(LAS u32x4*)(KTs + r * 72 + c8) = *(const u32x4*)(ktb + (unsigned)(r * NTOK + c8)); }
            }
            bf16x8 vf[2];
#pragma unroll
            for (int kk = 0; kk < 2; ++kk) vf[kk] = *(const bf16x8*)(vtb + (unsigned)(er * NTOK + 32 * kk + g4 * 8));
            __syncthreads();
            if (dir) {
#pragma unroll
                for (int pi2 = 0; pi2 < 2; ++pi2) {
                    const int pi = 2 * wid + pi2, js = pi >> 2, is = pi & 3;
                    f32x4 a = {0.f, 0.f, 0.f, 0.f};
#pragma unroll
                    for (int s8 = 0; s8 < 8; ++s8) {
                        const bf16x8 kf = *(const LAS bf16x8*)(Ks + (16 * js + er) * 264 + 32 * s8 + g4 * 8);
                        const bf16x8 qf = *(const LAS bf16x8*)(Qs + (16 * is + er) * 264 + 32 * s8 + g4 * 8);
                        a = mfma16(kf, qf, a);
                    }
                    const int i = 16 * is + er;
#pragma unroll
                    for (int j4 = 0; j4 < 4; ++j4) {
                        const int j = 16 * js + g4 * 4 + j4, dd = i - j;
                        const float dv = dd > 0 ? __expf(lgf * (float)dd) : (dd < 0 ? __expf(lgb * (float)(-dd)) : 2.0f);
                        a[j4] *= dv;
                    }
                    *(LAS u32x2*)(Ps + i * 72 + 16 * js + g4 * 4) = pack4(a);
                }
                __syncthreads();
            }
            f32x4 a2[4];
#pragma unroll
            for (int is = 0; is < 4; ++is) a2[is] = (f32x4){0.f, 0.f, 0.f, 0.f};
#pragma unroll
            for (int s8 = 0; s8 < 8; ++s8) {
                const bf16x8 sf = pack8(S[2 * s8], S[2 * s8 + 1]);
#pragma unroll
                for (int is = 0; is < 4; ++is) {
                    const LAS bf16_t* qp = Qs + (16 * is + er) * 264 + 32 * s8 + g4 * 4;
                    const bf16x8 qf = cat44(*(const LAS bf16x4*)qp, *(const LAS bf16x4*)(qp + 16));
                    a2[is] = mfma16(sf, qf, a2[is]);
                }
            }
#pragma unroll
            for (int is = 0; is < 4; ++is) {
                f32x4 o = a2[is] * __expf(lg * (float)(dir ? 16 * is + er + 1 : 64 - 16 * is - er));
                bf16_t* op = ob + (unsigned)((16 * is + er) * 4096 + g4 * 4);
                if (dir) {
                    f32x4 a1 = {0.f, 0.f, 0.f, 0.f};
#pragma unroll
                    for (int kk = 0; kk < 2; ++kk) { const bf16x8 pf = *(const LAS bf16x8*)(Ps + (16 * is + er) * 72 + 32 * kk + g4 * 8); a1 = mfma16(vf[kk], pf, a1); }
                    o += a1; o += unpack4(*(const u32x2*)op);
                }
                *(u32x2*)op = pack4(o);
            }
            bf16x8 vs[2];
#pragma unroll
            for (int kk = 0; kk < 2; ++kk) {
                float fu[8];
#pragma unroll
                for (int i = 0; i < 8; ++i) { const int j = 32 * kk + g4 * 8 + i; fu[i] = __expf(lg * (float)(dir ? 63 - j : j)); }
                vs[kk] = scale8(vf[kk], fu);
            }
            __builtin_amdgcn_sched_barrier(0);
#pragma unroll
            for (int t = 0; t < 16; ++t) {
                S[t] *= gch;
#pragma unroll
                for (int kk = 0; kk < 2; ++kk) { const bf16x8 af = *(const LAS bf16x8*)(KTs + (16 * t + er) * 72 + 32 * kk + g4 * 8); S[t] = mfma16(af, vs[kk], S[t]); }
                if ((t & 3) == 3) __builtin_amdgcn_sched_barrier(0);
            }
        }
        if (!sample) {
            float* so = p->out + (dir ? (size_t)18874368 : (size_t)35651584) + ((size_t)((seq - 4) * 8 + h) * 256) * 512 + es * 128 + wid * 16 + er_;
#pragma unroll
            for (int t = 0; t < 16; ++t)
#pragma unroll
                for (int j = 0; j < 4; ++j) { so[(size_t)(16 * t + g4_ * 4 + j) * 512] = S[t][j]; if (j == 3) __builtin_amdgcn_sched_barrier(0); }
        }
    }
}

__device__ __forceinline__ void ret_phase(ParamsCP p, LAS unsigned char* lds, int tid, int wid, int lane) {
    for (int slot = blockIdx.x; slot < 256; slot += gridDim.x) {
        if (slot < 128) { ret_item(p, lds, slot >> 5, (slot >> 2) & 7, slot & 3, tid, wid, lane); }
        else {
#pragma unroll 1
            for (int k = 0; k < 4; ++k) { const int j = (slot - 128) * 4 + k; ret_item(p, lds, 4 + (j >> 5), (j >> 2) & 7, j & 3, tid, wid, lane); }
        }
    }
}

__device__ __forceinline__ void gn_phase(ParamsCP p, int wid, int lane) {
    for (int pr = blockIdx.x * 8 + wid; pr < NTOK * 8; pr += gridDim.x * 8) {
        const int tok = pr >> 3, h = pr & 7;
        const size_t base = (size_t)tok * 4096 + h * 512 + lane * 8;
        const u32x4 raw = *(const u32x4*)(p->o1 + base);
        float x[8]; float s = 0.f, ss = 0.f;
#pragma unroll
        for (int i = 0; i < 4; ++i) { x[2 * i] = bflo(raw[i]); x[2 * i + 1] = bfhi(raw[i]); s += x[2 * i] + x[2 * i + 1]; ss += x[2 * i] * x[2 * i] + x[2 * i + 1] * x[2 * i + 1]; }
        s = wave_sum(s); ss = wave_sum(ss);
        const float mu = s * (1.0f / 512.0f), var = ss * (1.0f / 512.0f) - mu * mu, rs = rsqrtf(var + EPSN);
        const f32x4 g0 = *(const f32x4*)(p->ret_gn_g + h * 512 + lane * 8), g1 = *(const f32x4*)(p->ret_gn_g + h * 512 + lane * 8 + 4);
        const u32x4 sg = *(const u32x4*)(p->sg1 + base);
        f32x4 o0, o1;
#pragma unroll
        for (int i = 0; i < 2; ++i) {
            o0[2 * i] = (x[2 * i] - mu) * rs * g0[2 * i] * bflo(sg[i]); o0[2 * i + 1] = (x[2 * i + 1] - mu) * rs * g0[2 * i + 1] * bfhi(sg[i]);
            o1[2 * i] = (x[4 + 2 * i] - mu) * rs * g1[2 * i] * bflo(sg[2 + i]); o1[2 * i + 1] = (x[4 + 2 * i + 1] - mu) * rs * g1[2 * i + 1] * bfhi(sg[2 + i]);
        }
        *(u32x4*)(p->a2 + base) = pack8u(o0, o1);
    }
}

constexpr int NPHASE = 17;
__global__ void __launch_bounds__(512, 2) fwd_megakernel(Params p_unused, int ph_lo, int ph_hi) {
    extern __shared__ __attribute__((aligned(16))) unsigned char shm[];
    LAS unsigned char* lds = (LAS unsigned char*)shm;
    cg::grid_group grid = cg::this_grid();
    const int tid0 = threadIdx.x;
#pragma unroll 1
    for (int ph = ph_lo; ph < ph_hi; ++ph) {
        if (ph > ph_lo) grid.sync();
        int tid = tid0; asm volatile("" : "+v"(tid));
        ParamsCP p = (ParamsCP)__builtin_amdgcn_kernarg_segment_ptr(); asm volatile("" : "+s"(p));
        const int wid = __builtin_amdgcn_readfirstlane(tid >> 6), lane = tid & 63;
        int kind, L = 0;
        if (ph == 0) kind = 0;
        else if (ph == 16) kind = 11;
        else if (ph <= 7) { L = 0; const int k = ph - 1; kind = k == 0 ? 1 : k == 1 ? 2 : k == 2 ? 3 : k == 3 ? 4 : k == 4 ? 5 : k == 5 ? 6 : 7; }
        else { L = 1; const int k = ph - 8; kind = k == 0 ? 1 : k == 1 ? 8 : k == 2 ? 9 : k == 3 ? 10 : k == 4 ? 4 : k == 5 ? 5 : k == 6 ? 6 : 7; }
        const float* modL = p->mod + (size_t)L * 5 * MODW;
#ifndef PH_MASK
#define PH_MASK 0xfff
#endif
        if (!((PH_MASK >> kind) & 1)) continue;
        switch (kind) {
        case 0: phase0(p, lds, tid); break;
        case 1: {
            const float* xlo = L == 0 ? p->x_prompt : p->xb; const float* xhi = L == 0 ? p->x_sample - (size_t)TPR * DM : p->xb;
            norm_phase(xlo, xhi, p->norm_mix_g + L * DM, modL, modL + 2048, p->h, wid, lane);
        } break;
        case 2: { EpiInProj0 E; E.q = p->q0; E.k = p->k0; E.vt = p->vt0; E.u = p->u0; E.vg = p->vg0; E.outk = p->out + 16777216; E.outv = p->out + 17825792;
                  run_gemm(lds, p->h, p->wt_in0, 3584, 2048, E); } break;
        case 3: sgu_phase(p, lds, tid, wid, lane); attn_phase(p, wid, lane); break;
        case 4: case 7: {
            EpiResid E; const bf16_t *A, *Bt; int K;
            if (kind == 4) {
                if (L == 0) { A = p->ag; Bt = p->wt_out0; K = 2048; E.res_lo = p->x_prompt; E.res_hi = p->x_sample - (size_t)TPR * DM; }
                else { A = p->a2; Bt = p->wt_out1; K = 4096; E.res_lo = p->xb; E.res_hi = p->xb; }
                E.gate = modL + 4096; E.out = p->xa;
            } else { A = p->act; Bt = L == 0 ? p->wt_f2a : p->wt_f2b; K = 5632; E.res_lo = p->xa; E.res_hi = p->xa; E.gate = modL + 10240; E.out = p->xb; }
            run_gemm(lds, A, Bt, 2048, K, E);
        } break;
        case 5: norm_phase(p->xa, p->xa, p->norm_ffn_g + L * DM, modL + 6144, modL + 8192, p->h, wid, lane); break;
        case 6: { EpiSwiGLU E; E.act = p->act; run_gemm(lds, p->h, L == 0 ? p->wt_f1a : p->wt_f1b, 11264, 2048, E); } break;
        case 8: { EpiRetIn E; E.q1 = p->q1; E.k1 = p->k1; E.sg1 = p->sg1; E.kt1 = p->kt1; E.vt1 = p->vt1; run_gemm(lds, p->h, p->wt_in1, 12288, 2048, E); } break;
        case 9: ret_phase(p, lds, tid, wid, lane); break;
        case 10: gn_phase(p, wid, lane); break;
        default: final_norm_phase(p->xb, p->final_g, p->out, wid, lane); break;
        }
    }
}

extern "C" void kernel_launch(void* const* d_in, const int* in_sizes, int n_in, void* d_out, int out_size, void* d_ws, size_t ws_size, hipStream_t stream) {
    (void)in_sizes; (void)n_in; (void)out_size; (void)ws_size;
    static int grid_blocks = 0;
    if (!grid_blocks) {
        hipFuncSetAttribute((const void*)fwd_megakernel, hipFuncAttributeMaxDynamicSharedMemorySize, LDS_BYTES);
        int dev = 0, cus = 0, per_cu = 0;
        hipGetDevice(&dev);
        hipDeviceGetAttribute(&cus, hipDeviceAttributeMultiprocessorCount, dev);
        hipOccupancyMaxActiveBlocksPerMultiprocessor(&per_cu, fwd_megakernel, 512, LDS_BYTES);
        if (per_cu < 1) per_cu = 1;
        if (per_cu > 1) per_cu = 1;
        grid_blocks = cus * per_cu;
    }
    Params hp;
    memset(&hp, 0, sizeof(hp));
    const float* const* in = (const float* const*)d_in;
    hp.x_prompt = in[0]; hp.x_sample = in[1]; hp.cache_k = in[2]; hp.cache_v = in[3]; hp.st_f = in[4]; hp.st_b = in[5]; hp.c = in[6]; hp.c_ctx = in[7];
    hp.ada_w = in[8]; hp.ada_b = in[9]; hp.norm_mix_g = in[10]; hp.norm_ffn_g = in[11]; hp.even_w_in = in[12]; hp.even_w_out = in[13]; hp.attn_sink = in[14];
    hp.sgu_ln_g = in[15]; hp.sgu_ln_b = in[16]; hp.sgu_w = in[17]; hp.sgu_b = in[18]; hp.ret_w_in = in[19]; hp.ret_w_out = in[20]; hp.ret_gn_g = in[21];
    hp.ret_dec_f = in[22]; hp.ret_dec_b = in[23]; hp.ffn_w_gate = in[24]; hp.ffn_w_up = in[25]; hp.ffn_w_down = in[26]; hp.final_g = in[27];
    hp.out = (float*)d_out;
    unsigned char* w = (unsigned char*)d_ws; size_t off = 0;
    auto take = [&](size_t bytes) { unsigned char* r = w + off; off += (bytes + 255) & ~(size_t)255; return r; };
    hp.wt_in0 = (bf16_t*)take((size_t)3584 * 2048 * 2); hp.wt_out0 = (bf16_t*)take((size_t)2048 * 2048 * 2);
    hp.wt_f1a = (bf16_t*)take((size_t)11264 * 2048 * 2); hp.wt_f1b = (bf16_t*)take((size_t)11264 * 2048 * 2);
    hp.wt_f2a = (bf16_t*)take((size_t)2048 * 5632 * 2); hp.wt_f2b = (bf16_t*)take((size_t)2048 * 5632 * 2);
    hp.wt_in1 = (bf16_t*)take((size_t)12288 * 2048 * 2); hp.wt_out1 = (bf16_t*)take((size_t)2048 * 4096 * 2);
    hp.mod = (float*)take((size_t)2 * 5 * MODW * 4);
    hp.h = (bf16_t*)take((size_t)NTOK * DM * 2);
    hp.xa = (float*)take((size_t)NTOK * DM * 4); hp.xb = (float*)take((size_t)NTOK * DM * 4);
    hp.act = (bf16_t*)take((size_t)NTOK * 5632 * 2); hp.a2 = hp.act;
    hp.o1 = (bf16_t*)take((size_t)NTOK * 4096 * 2);
    unsigned char* ra = w + off; const size_t ra_off = off;
    hp.q1 = (bf16_t*)take((size_t)NTOK * 2048 * 2); hp.k1 = (bf16_t*)take((size_t)NTOK * 2048 * 2); hp.sg1 = (bf16_t*)take((size_t)NTOK * 4096 * 2);
    hp.kt1 = (bf16_t*)take((size_t)2048 * NTOK * 2); hp.vt1 = (bf16_t*)take((size_t)4096 * NTOK * 2);
    off = ra_off; (void)ra;
    hp.q0 = (bf16_t*)take((size_t)NTOK * 1024 * 2); hp.k0 = (bf16_t*)take((size_t)NTOK * 256 * 2); hp.vt0 = (bf16_t*)take((size_t)256 * NTOK * 2);
    hp.u0 = (bf16_t*)take((size_t)NTOK * 1024 * 2); hp.vg0 = (bf16_t*)take((size_t)NTOK * 1024 * 2);
    hp.ck = (bf16_t*)take((size_t)4 * 512 * 256 * 2); hp.cvt = (bf16_t*)take((size_t)4 * 256 * 512 * 2); hp.ag = (bf16_t*)take((size_t)NTOK * 2048 * 2);
    hipMemsetAsync(hp.mod, 0, (size_t)2 * 5 * MODW * 4, stream);
#if defined(MK_MULTI)
    for (int ph = 0; ph < NPHASE; ++ph) hipLaunchKernelGGL(fwd_megakernel, dim3(grid_blocks), dim3(512), LDS_BYTES, stream, hp, ph, ph + 1);
#else
    int lo = 0, hi = NPHASE;
    void* args[] = {&hp, &lo, &hi};
    hipError_t e = hipLaunchCooperativeKernel((void*)fwd_megakernel, dim3(grid_blocks), dim3(512), args, LDS_BYTES, stream);
    if (e != hipSuccess) fprintf(stderr, "cooperative launch failed: %s (grid %d)\n", hipGetErrorString(e), grid_blocks);
#endif
}
```

```cpp
#include <hip/hip_runtime.h>
#include <hip/hip_cooperative_groups.h>
#include <cstdio>
#include <cstring>
#include <cmath>

namespace pg8 {
#define PG8_LAS __attribute__((address_space(3)))
typedef unsigned short bf16_t;
typedef short bf16x8 __attribute__((ext_vector_type(8)));
typedef float f32x4 __attribute__((ext_vector_type(4)));
typedef unsigned u32x4 __attribute__((ext_vector_type(4)));
constexpr int BM = 256, BK = 64, HALF = 128, HTB = HALF * BK * 2  , STAGE_BYTES = 8 * HTB, NXCD = 8, WGM = 8;

__host__ __device__ __forceinline__ int lds_byte(int r, int c) { const int st = (r >> 4) * 2 + (c >> 5), rr = r & 15, cc = c & 31, ob = rr * 64 + cc * 2; return st * 1024 + (ob ^ (((ob >> 9) & 1) << 5)); }
__host__ __device__ __forceinline__ void stage_rc(int b, int& R, int& C) { const int st = b / 1024, sb = b % 1024, swz = sb ^ (((sb >> 9) & 1) << 5); R = (st >> 1) * 16 + swz / 64; C = (st & 1) * 32 + (swz % 64) / 2; }
__host__ __device__ __forceinline__ int perm32(int rho) { const int n = rho >> 4, i = rho & 15; return 8 * (i >> 2) + 4 * n + (i & 3); }

struct Unit { int pm, pn; };
struct Gemm { const bf16_t* A; const bf16_t* Bt; int M, N, K; };

struct StaticOrder {
    int nM, nN, nwg, G, c;
    __host__ __device__ void init(int M, int N, int G_, int c_) { nM = M / BM; nN = N / BM; nwg = nM * nN; G = G_; c = c_; }
    __host__ __device__ bool next(int i, Unit& u) const {
        const long L = (long)i * G + c; if (L >= nwg) return false;
        int wgid = (int)L; { const int q = nwg / NXCD, r = nwg % NXCD, xcd = wgid % NXCD, off = wgid / NXCD; wgid = (xcd < r ? xcd * (q + 1) : r * (q + 1) + (xcd - r) * q) + off; }
        const int nig = WGM * nN, gid = wgid / nig, fm = gid * WGM, gsz = (nM - fm) < WGM ? (nM - fm) : WGM;
        u.pm = fm + ((wgid % nig) % gsz); u.pn = (wgid % nig) / gsz; return true;
    }
    __device__ __forceinline__ void a_ready(const Unit&) const {}
    __device__ __forceinline__ void done(const Unit&) const {}
};
template <class Epi, class Sched, bool STAMP = false>
__device__ __forceinline__ void gemm_phase(PG8_LAS unsigned char* lds, const Gemm g, const Sched& S, const Epi& E, unsigned long long* stamps) {
    const int tid = threadIdx.x, wid = __builtin_amdgcn_readfirstlane(tid >> 6), lane = tid & 63, wr = wid >> 2, wc = wid & 3, fr = lane & 15, fq = lane >> 4;
    const int K = g.K, nt = K / BK;
    int ts_lo = 0, ts_hi = 0, nts = 0; const unsigned long long rt_entry = STAMP ? (unsigned long long)wall_clock64() : 0ull;
#define PG8_STAMP() do { if (STAMP && wid == 0 && nts < 64) { const unsigned long long _c = (unsigned long long)clock64(); \
        ts_lo = (lane == nts) ? (int)(unsigned)_c : ts_lo; ts_hi = (lane == nts) ? (int)(unsigned)(_c >> 32) : ts_hi; ++nts; } } while (0)
    PG8_STAMP();
    unsigned voffA[2], voffB[2];
#pragma unroll
    for (int i = 0; i < 2; ++i) { int R, C; stage_rc(tid * 16 + i * 8192, R, C); const int Rb = Epi::PERM ? ((R & ~31) + perm32(R & 31)) : R;
        voffA[i] = (unsigned)(R * K + C) * 2u; voffB[i] = (unsigned)(Rb * K + C) * 2u; }
    const size_t kstep = (size_t)(BK * 2);
    const size_t hstep = (size_t)HALF * K * 2;
    const size_t tstep = 2 * hstep;
    const unsigned ldsw = (unsigned)wid * 1024u;
    const int aoff = lds_byte(wr * 64 + fr, fq * 8), boff = lds_byte(wc * 32 + fr, fq * 8);
#define PG8_SA(b, h) (((b) * 2 + (h)) * HTB)
#define PG8_SB(b, h) ((4 + (b) * 2 + (h)) * HTB)
#define PG8_STAGE(bufoff, gbase, voff) do { _Pragma("unroll") for (int _i = 0; _i < 2; ++_i) \
        __builtin_amdgcn_global_load_lds((const unsigned*)((const char*)(gbase) + (voff)[_i]), (PG8_LAS unsigned*)(lds + (bufoff) + ldsw + _i * 8192), 16, 0, 0); } while (0)
#define PG8_LDA(dst, b, h) do { _Pragma("unroll") for (int m = 0; m < 4; ++m) _Pragma("unroll") for (int k = 0; k < 2; ++k) dst[m][k] = *(const PG8_LAS bf16x8*)(lds + PG8_SA(b, h) + aoff + m * 2048 + k * 1024); } while (0)
#define PG8_LDB(dst, b, h) do { _Pragma("unroll") for (int n = 0; n < 2; ++n) _Pragma("unroll") for (int k = 0; k < 2; ++k) dst[n][k] = *(const PG8_LAS bf16x8*)(lds + PG8_SB(b, h) + boff + n * 2048 + k * 1024); } while (0)
#define PG8_MMA(ai, bj, At, Bt) do { __builtin_amdgcn_s_setprio(1); _Pragma("unroll") for (int m = 0; m < 4; ++m) _Pragma("unroll") for (int n = 0; n < 2; ++n) _Pragma("unroll") for (int k = 0; k < 2; ++k) \
        acc[ai][bj][m][n] = __builtin_amdgcn_mfma_f32_16x16x32_bf16(Bt[n][k], At[m][k], acc[ai][bj][m][n], 0, 0, 0); __builtin_amdgcn_s_setprio(0); } while (0)
#define PG8_WAIT_V(n) asm volatile("s_waitcnt vmcnt(" #n ")" ::: "memory")
#define PG8_WAIT_L(n) asm volatile("s_waitcnt lgkmcnt(" #n ")" ::: "memory")
#define PG8_BAR __builtin_amdgcn_s_barrier()
#define PG8_SCHED __builtin_amdgcn_sched_barrier(0)
    Unit cur, nxt; int ui = 0;
    if (!S.next(0, cur)) return;
    f32x4 acc[2][2][4][2];
#pragma unroll
    for (int a = 0; a < 2; ++a)
#pragma unroll
        for (int b = 0; b < 2; ++b)
#pragma unroll
            for (int m = 0; m < 4; ++m)
#pragma unroll
                for (int n = 0; n < 2; ++n) acc[a][b][m][n] = (f32x4){0.f, 0.f, 0.f, 0.f};
    bf16x8 At[4][2], B0[2][2], B1[2][2];
    const char* cA = (const char*)g.A + (size_t)cur.pm * tstep; const char* cB = (const char*)g.Bt + (size_t)cur.pn * tstep;
    S.a_ready(cur);
    PG8_STAGE(PG8_SB(0, 0), cB, voffB); PG8_STAGE(PG8_SA(0, 0), cA, voffA); PG8_STAGE(PG8_SB(0, 1), cB + hstep, voffB); PG8_STAGE(PG8_SA(0, 1), cA + hstep, voffA);
    if (wr == 1) PG8_BAR;
    PG8_WAIT_V(4); PG8_BAR;
    PG8_STAGE(PG8_SB(1, 0), cB + kstep, voffB); PG8_STAGE(PG8_SA(1, 0), cA + kstep, voffA); PG8_STAGE(PG8_SB(1, 1), cB + hstep + kstep, voffB);
    PG8_WAIT_V(6); PG8_BAR;
    PG8_STAMP();
    for (;;) {
        const bool has_next = S.next(ui + 1, nxt);
        const char* nA = has_next ? (const char*)g.A + (size_t)nxt.pm * tstep : cA; const char* nB = has_next ? (const char*)g.Bt + (size_t)nxt.pn * tstep : cB;
        for (int t = 0; t < nt; t += 2) {
            const bool last = (t == nt - 2);
            const char* a1 = cA + (size_t)(t + 1) * kstep;
            const char* a2 = last ? nA : cA + (size_t)(t + 2) * kstep; const char* b2 = last ? nB : cB + (size_t)(t + 2) * kstep;
            const char* a3 = a2 + kstep; const char* b3 = b2 + kstep;
            if (last && has_next) S.a_ready(nxt);
            PG8_LDB(B0, 0, 0); PG8_SCHED; PG8_LDA(At, 0, 0); PG8_STAGE(PG8_SA(1, 1), a1 + hstep, voffA);
            PG8_WAIT_L(8); PG8_BAR; PG8_WAIT_L(0); PG8_MMA(0, 0, At, B0); PG8_BAR; PG8_SCHED;
            PG8_LDB(B1, 0, 1); PG8_STAGE(PG8_SB(0, 0), b2, voffB);
            PG8_BAR; PG8_WAIT_L(0); PG8_MMA(0, 1, At, B1); PG8_BAR;
            PG8_LDA(At, 0, 1); PG8_STAGE(PG8_SA(0, 0), a2, voffA);
            PG8_BAR; PG8_WAIT_L(0); PG8_MMA(1, 0, At, B0); PG8_BAR; PG8_SCHED;
            PG8_STAGE(PG8_SB(0, 1), b2 + hstep, voffB);
            PG8_WAIT_V(6); PG8_BAR; PG8_MMA(1, 1, At, B1); PG8_BAR;
            PG8_LDB(B0, 1, 0); PG8_SCHED; PG8_LDA(At, 1, 0); PG8_STAGE(PG8_SA(0, 1), a2 + hstep, voffA);
            PG8_WAIT_L(8); PG8_BAR; PG8_WAIT_L(0); PG8_MMA(0, 0, At, B0); PG8_BAR; PG8_SCHED;
            PG8_LDB(B1, 1, 1); PG8_STAGE(PG8_SB(1, 0), b3, voffB);
            PG8_BAR; PG8_WAIT_L(0); PG8_MMA(0, 1, At, B1); PG8_BAR;
            PG8_LDA(At, 1, 1); PG8_STAGE(PG8_SA(1, 0), a3, voffA);
            PG8_BAR; PG8_WAIT_L(0); PG8_MMA(1, 0, At, B0); PG8_BAR; PG8_SCHED;
            PG8_STAGE(PG8_SB(1, 1), b3 + hstep, voffB);
            PG8_WAIT_V(6); PG8_BAR; PG8_MMA(1, 1, At, B1); PG8_BAR;
        }
        PG8_STAMP();
        if constexpr (!Epi::AFTER_DRAIN) { E(acc, cur, wr, wc, fr, fq); S.done(cur); }
        PG8_STAMP();
        if (!has_next) break;
#pragma unroll
        for (int a = 0; a < 2; ++a)
#pragma unroll
            for (int b = 0; b < 2; ++b)
#pragma unroll
                for (int m = 0; m < 4; ++m)
#pragma unroll
                    for (int n = 0; n < 2; ++n) acc[a][b][m][n] = (f32x4){0.f, 0.f, 0.f, 0.f};
        cur = nxt; cA = nA; cB = nB; ++ui;
    }
    PG8_WAIT_V(0);
    if (wr == 0) PG8_BAR;
    PG8_BAR;
    if constexpr (Epi::AFTER_DRAIN) { E.fused(acc, cur, wr, wc, fr, fq, lds, wid, lane); S.done(cur); }
    PG8_STAMP();
    if (STAMP && wid == 0) { stamps[lane] = lane < nts ? (((unsigned long long)(unsigned)ts_hi << 32) | (unsigned)ts_lo) : 0ull;
        if (lane == 62) stamps[62] = rt_entry; if (lane == 63) stamps[63] = (unsigned long long)wall_clock64(); }
#undef PG8_STAMP
#undef PG8_SA
#undef PG8_SB
#undef PG8_STAGE
#undef PG8_LDA
#undef PG8_LDB
#undef PG8_MMA
#undef PG8_WAIT_V
#undef PG8_WAIT_L
#undef PG8_BAR
#undef PG8_SCHED
}
}


namespace cg = cooperative_groups;
using pg8::bf16_t; using pg8::bf16x8; using pg8::f32x4; using pg8::u32x4; using pg8::Unit;
#define LAS __attribute__((address_space(3)))
typedef short bf16x4 __attribute__((ext_vector_type(4)));
typedef unsigned u32x2 __attribute__((ext_vector_type(2)));

constexpr int NTOK = 8192, DM = 2048, TPR = 4096;
constexpr float EPSN = 1e-6f;
constexpr int MODW = 12288;
constexpr int LDS_BYTES = 131072 + 256;

struct Params {
    const float *x_prompt, *x_sample, *cache_k, *cache_v, *st_f, *st_b, *c, *c_ctx, *ada_w, *ada_b, *norm_mix_g, *norm_ffn_g;
    const float *even_w_in, *even_w_out, *attn_sink, *sgu_ln_g, *sgu_ln_b, *sgu_w, *sgu_b, *ret_w_in, *ret_w_out, *ret_gn_g, *ret_dec_f, *ret_dec_b;
    const float *ffn_w_gate, *ffn_w_up, *ffn_w_down, *final_g;
    float* out;
    bf16_t *wt_in0, *wt_out0, *wt_f1a, *wt_f1b, *wt_f2a, *wt_f2b, *wt_in1, *wt_out1;
    float* mod; float* stat; unsigned* bar;
    bf16_t* h;
    bf16_t *q0, *k0, *vt0, *u0, *vg0, *ck, *cvt, *ag;
    float *xa, *xb;
    bf16_t* act;
    bf16_t *q1, *k1, *sg1, *kt1, *vt1, *o1, *a2;
};
typedef const Params __attribute__((address_space(4))) * ParamsCP;


__device__ __forceinline__ unsigned pk2(float lo, float hi) { unsigned r; asm("v_cvt_pk_bf16_f32 %0, %1, %2" : "=v"(r) : "v"(lo), "v"(hi)); return r; }
__device__ __forceinline__ bf16_t f2bf(float f) { return (bf16_t)(pk2(f, 0.f) & 0xffffu); }
__device__ __forceinline__ float bflo(unsigned w) { return __uint_as_float(w << 16); }
__device__ __forceinline__ float bfhi(unsigned w) { return __uint_as_float(w & 0xffff0000u); }
__device__ __forceinline__ u32x2 pack4(f32x4 a) { u32x2 w; w.x = pk2(a[0], a[1]); w.y = pk2(a[2], a[3]); return w; }
__device__ __forceinline__ u32x4 pack8u(f32x4 a, f32x4 b) { u32x4 w; w.x = pk2(a[0], a[1]); w.y = pk2(a[2], a[3]); w.z = pk2(b[0], b[1]); w.w = pk2(b[2], b[3]); return w; }
__device__ __forceinline__ bf16x8 pack8(f32x4 a, f32x4 b) { return __builtin_bit_cast(bf16x8, pack8u(a, b)); }
__device__ __forceinline__ f32x4 unpack4(u32x2 w) { f32x4 r; r[0] = bflo(w.x); r[1] = bfhi(w.x); r[2] = bflo(w.y); r[3] = bfhi(w.y); return r; }
__device__ __forceinline__ bf16x8 cat44(bf16x4 a, bf16x4 b) { return __builtin_shufflevector(a, b, 0, 1, 2, 3, 4, 5, 6, 7); }
__device__ __forceinline__ f32x4 mfma16(bf16x8 a, bf16x8 b, f32x4 c) { return __builtin_amdgcn_mfma_f32_16x16x32_bf16(a, b, c, 0, 0, 0); }
__device__ __forceinline__ float siluf(float v) { return v / (1.0f + __expf(-v)); }
__device__ __forceinline__ float gelu_tanh(float v) { const float y = 0.7978845608028654f * (v + 0.044715f * v * v * v); return v / (1.0f + __expf(-2.0f * y)); }
__device__ __forceinline__ float wave_sum(float v) {
#pragma unroll
    for (int o = 32; o >= 1; o >>= 1) v += __shfl_xor(v, o);
    return v;
}

struct EpiInProj0 {
    static constexpr bool PERM = false, AFTER_DRAIN = false;
    bf16_t *q, *k, *vt, *u, *vg; float *outk, *outv, *stat;
    __device__ __forceinline__ void operator()(const f32x4 (&acc)[2][2][4][2], const Unit& un, int wr_, int wc_, int fr_, int fq_) const {
        int wr = wr_, wc = wc_, fr = fr_, fq = fq_; asm volatile("" : "+s"(wr), "+s"(wc), "+v"(fr), "+v"(fq));
        const int pn = un.pn;
        const int row0 = un.pm * 256 + wr * 64 + fr;
        const int cb = wc * 32 + 4 * fq;
        if (pn < 5) {
            const bool isq = pn < 4;
            const bool rope = un.pm >= 16;
            float inv[4];
#pragma unroll
            for (int j = 0; j < 4; ++j) inv[j] = __builtin_amdgcn_exp2f(-(float)(4 * fq + j) * 0.8304820237218406f);
#pragma unroll
            for (int ai = 0; ai < 2; ++ai)
#pragma unroll
                for (int m = 0; m < 4; ++m) {
                    const int row = row0 + ai * 128 + m * 16;
                    float cs[4], sn[4];
                    if (rope) {
                        const int pos = (row - TPR) & 1023;
                        const float t = (wc & 1) ? (float)(pos & 63) : (float)(pos >> 6);
#pragma unroll
                        for (int j = 0; j < 4; ++j) { const float a = t * inv[j]; cs[j] = __cosf(a); sn[j] = __sinf(a); }
                    } else {
#pragma unroll
                        for (int j = 0; j < 4; ++j) { cs[j] = 1.f; sn[j] = 0.f; }
                    }
#pragma unroll
                    for (int bj = 0; bj < 2; ++bj) {
                        const f32x4 x1 = acc[ai][bj][m][0], x2 = acc[ai][bj][m][1];
                        f32x4 o1, o2;
#pragma unroll
                        for (int j = 0; j < 4; ++j) { o1[j] = x1[j] * cs[j] - x2[j] * sn[j]; o2[j] = x2[j] * cs[j] + x1[j] * sn[j]; }
                        const int c = bj * 128 + cb;
                        if (isq) {
                            bf16_t* d = q + (size_t)row * 1024 + pn * 256 + c;
                            *(u32x2*)d = pack4(o1); *(u32x2*)(d + 16) = pack4(o2);
                        } else {
                            bf16_t* d = k + (size_t)row * 256 + c;
                            *(u32x2*)d = pack4(o1); *(u32x2*)(d + 16) = pack4(o2);
                            if (!rope) { float* ok = outk + (size_t)row * 256 + c; *(f32x4*)ok = x1; *(f32x4*)(ok + 16) = x2; }
                        }
                    }
                    __builtin_amdgcn_sched_barrier(0);
                }
        } else if (pn == 5) {
            const bool prm = un.pm < 16;
#pragma unroll
            for (int ai = 0; ai < 2; ++ai)
#pragma unroll
                for (int m = 0; m < 4; ++m) {
                    const int row = row0 + ai * 128 + m * 16;
#pragma unroll
                    for (int bj = 0; bj < 2; ++bj)
#pragma unroll
                        for (int n = 0; n < 2; ++n) {
                            const f32x4 v = acc[ai][bj][m][n];
                            const int c = bj * 128 + cb + n * 16;
                            if (prm) *(f32x4*)(outv + (size_t)row * 256 + c) = v;
#pragma unroll
                            for (int j = 0; j < 4; ++j) vt[(size_t)(c + j) * NTOK + row] = f2bf(v[j]);
                            __builtin_amdgcn_sched_barrier(0);
                        }
                }
        } else {
            const bool isvg = pn >= 10;
            bf16_t* dst = pn < 10 ? u + (pn - 6) * 256 : vg + (pn - 10) * 256;
#pragma unroll
            for (int ai = 0; ai < 2; ++ai)
#pragma unroll
                for (int m = 0; m < 4; ++m) {
                    const int row = row0 + ai * 128 + m * 16;
                    float ssum = 0.f, ssq = 0.f;
#pragma unroll
                    for (int bj = 0; bj < 2; ++bj)
#pragma unroll
                        for (int n = 0; n < 2; ++n) {
                            const f32x4 v = acc[ai][bj][m][n];
                            f32x4 o;
#pragma unroll
                            for (int j = 0; j < 4; ++j) { o[j] = gelu_tanh(v[j]); ssum += o[j]; ssq += o[j] * o[j]; }
                            *(u32x2*)(dst + (size_t)row * 1024 + bj * 128 + cb + n * 16) = pack4(o);
                        }
                    if (isvg) {
                        ssum += __shfl_xor(ssum, 16); ssum += __shfl_xor(ssum, 32); ssq += __shfl_xor(ssq, 16); ssq += __shfl_xor(ssq, 32);
                        if (fq == 0) { unsafeAtomicAdd(stat + 2 * row, ssum); unsafeAtomicAdd(stat + 2 * row + 1, ssq); }
                    }
                    __builtin_amdgcn_sched_barrier(0);
                }
        }
    }
};

struct EpiResid {
    static constexpr bool PERM = false, AFTER_DRAIN = false;
    const float *res_lo, *res_hi; const float* gate; float* out;
    __device__ __forceinline__ void operator()(const f32x4 (&acc)[2][2][4][2], const Unit& un, int wr_, int wc_, int fr_, int fq_) const {
        int wr = wr_, wc = wc_, fr = fr_, fq = fq_; asm volatile("" : "+s"(wr), "+s"(wc), "+v"(fr), "+v"(fq));
        const int cond = un.pm < 16 ? 0 : 1 + ((un.pm - 16) >> 2);
        const int row0 = un.pm * 256 + wr * 64 + fr, col0 = un.pn * 256 + wc * 32 + 4 * fq;
        const float* resb = un.pm < 16 ? res_lo : res_hi;
        f32x4 gv[2][2];
#pragma unroll
        for (int bj = 0; bj < 2; ++bj)
#pragma unroll
            for (int n = 0; n < 2; ++n) gv[bj][n] = *(const f32x4*)(gate + (size_t)cond * MODW + col0 + bj * 128 + n * 16);
#pragma unroll
        for (int ai = 0; ai < 2; ++ai)
#pragma unroll
            for (int m = 0; m < 4; ++m) {
                const size_t ro = (size_t)(row0 + ai * 128 + m * 16) * DM + col0;
#pragma unroll
                for (int bj = 0; bj < 2; ++bj)
#pragma unroll
                    for (int n = 0; n < 2; ++n) {
                        const f32x4 r = *(const f32x4*)(resb + ro + bj * 128 + n * 16);
                        *(f32x4*)(out + ro + bj * 128 + n * 16) = r + gv[bj][n] * acc[ai][bj][m][n];
                    }
            }
    }
};

struct EpiSwiGLU {
    static constexpr bool PERM = true, AFTER_DRAIN = false;
    bf16_t* act;
    __device__ __forceinline__ void operator()(const f32x4 (&acc)[2][2][4][2], const Unit& un, int wr_, int wc_, int fr_, int fq_) const {
        int wr = wr_, wc = wc_, fr = fr_, fq = fq_; asm volatile("" : "+s"(wr), "+s"(wc), "+v"(fr), "+v"(fq));
        const int row0 = un.pm * 256 + wr * 64 + fr, col0 = un.pn * 128 + wc * 32 + 8 * fq;
#pragma unroll
        for (int ai = 0; ai < 2; ++ai)
#pragma unroll
            for (int m = 0; m < 4; ++m) {
                f32x4 o[2];
#pragma unroll
                for (int n = 0; n < 2; ++n)
#pragma unroll
                    for (int j = 0; j < 4; ++j) o[n][j] = siluf(acc[ai][0][m][n][j]) * acc[ai][1][m][n][j];
                *(u32x4*)(act + (size_t)(row0 + ai * 128 + m * 16) * 5632 + col0) = pack8u(o[0], o[1]);
            }
    }
};

struct EpiRetIn {
    static constexpr bool PERM = true, AFTER_DRAIN = false;
    bf16_t *q1, *k1, *sg1, *kt1, *vt1;
    __device__ __forceinline__ void operator()(const f32x4 (&acc)[2][2][4][2], const Unit& un, int wr_, int wc_, int fr_, int fq_) const {
        int wr = wr_, wc = wc_, fr = fr_, fq = fq_; asm volatile("" : "+s"(wr), "+s"(wc), "+v"(fr), "+v"(fq));
        const int pn = un.pn;
        const int row0 = un.pm * 256 + wr * 64 + fr, cb = wc * 32 + 8 * fq;
#pragma unroll
        for (int ai = 0; ai < 2; ++ai)
#pragma unroll
            for (int m = 0; m < 4; ++m) {
                const int row = row0 + ai * 128 + m * 16;
#pragma unroll
                for (int bj = 0; bj < 2; ++bj) {
                    f32x4 v0 = acc[ai][bj][m][0], v1 = acc[ai][bj][m][1];
                    const int c = bj * 128 + cb;
                    if (pn < 8) {
                        *(u32x4*)(q1 + (size_t)row * 2048 + pn * 256 + c) = pack8u(v0, v1);
                    } else if (pn < 16) {
                        v0 *= 0.0625f; v1 *= 0.0625f;
                        const int cc = (pn - 8) * 256 + c;
                        *(u32x4*)(k1 + (size_t)row * 2048 + cc) = pack8u(v0, v1);
#pragma unroll
                        for (int j = 0; j < 4; ++j) { kt1[(size_t)(cc + j) * NTOK + row] = f2bf(v0[j]); kt1[(size_t)(cc + 4 + j) * NTOK + row] = f2bf(v1[j]); }
                    } else if (pn < 32) {
                        const int cc = (pn - 16) * 256 + c;
#pragma unroll
                        for (int j = 0; j < 4; ++j) { vt1[(size_t)(cc + j) * NTOK + row] = f2bf(v0[j]); vt1[(size_t)(cc + 4 + j) * NTOK + row] = f2bf(v1[j]); }
                    } else {
                        f32x4 s0, s1;
#pragma unroll
                        for (int j = 0; j < 4; ++j) { s0[j] = siluf(v0[j]); s1[j] = siluf(v1[j]); }
                        *(u32x4*)(sg1 + (size_t)row * 4096 + (pn - 32) * 256 + c) = pack8u(s0, s1);
                    }
                    __builtin_amdgcn_sched_barrier(0);
                }
            }
    }
};

template <class Epi>
__device__ __forceinline__ void run_gemm(LAS unsigned char* lds, const bf16_t* A, const bf16_t* Bt, int N, int K, const Epi& E) {
    pg8::Gemm g; g.A = A; g.Bt = Bt; g.M = NTOK; g.N = N; g.K = K;
    pg8::StaticOrder S; S.init(NTOK, N, (int)gridDim.x, (int)blockIdx.x);
    pg8::gemm_phase<Epi, pg8::StaticOrder, false>(lds, g, S, E, nullptr);
}

template <int MODE>
__device__ __forceinline__ void cvt_wt(const float* __restrict__ s0, const float* __restrict__ s1, int ld, bf16_t* __restrict__ dst, int K, int nrows, int tid) {
    const int nkb = K >> 5, nit = nkb * (nrows >> 9);
    for (int it = blockIdx.x; it < nit; it += gridDim.x) {
        const int kb = it % nkb, rb = it / nkb;
        const int r = rb * 512 + tid;
        const float* src; int col;
        if (MODE == 0) { src = s0; col = r; } else { src = ((r >> 7) & 1) ? s1 : s0; col = (r >> 8) * 128 + (r & 127); }
        const float* sp = src + (size_t)(kb * 32) * ld + col;
        float v[32];
#pragma unroll
        for (int i = 0; i < 32; ++i) v[i] = sp[(size_t)i * ld];
        u32x4* dp = (u32x4*)(dst + (size_t)r * K + kb * 32);
#pragma unroll
        for (int i = 0; i < 4; ++i) { u32x4 w; w.x = pk2(v[8 * i], v[8 * i + 1]); w.y = pk2(v[8 * i + 2], v[8 * i + 3]); w.z = pk2(v[8 * i + 4], v[8 * i + 5]); w.w = pk2(v[8 * i + 6], v[8 * i + 7]); dp[i] = w; }
    }
}

__device__ __forceinline__ void phase0(ParamsCP p, LAS unsigned char* lds, int tid, bool do_ada) {
    LAS float* sc = (LAS float*)lds;
    for (int i = tid; i < 5 * 2048; i += 512) { const int cnd = i >> 11, k = i & 2047; const float v = cnd == 0 ? p->c_ctx[k] : p->c[(cnd - 1) * 2048 + k]; sc[i] = siluf(v); }
    __syncthreads();
    for (int it = blockIdx.x; do_ada && it < 2 * 24 * 16; it += gridDim.x) {
        const int kb = it & 15, nb = (it >> 4) % 24, li = it / (16 * 24);
        const int n = nb * 512 + tid;
        const float* w = p->ada_w + ((size_t)li * 2048 + kb * 128) * MODW + n;
        float a0 = 0.f, a1 = 0.f, a2 = 0.f, a3 = 0.f, a4 = 0.f;
#pragma unroll 4
        for (int k = 0; k < 128; k += 4) {
            const float w0 = w[(size_t)k * MODW], w1 = w[(size_t)(k + 1) * MODW], w2 = w[(size_t)(k + 2) * MODW], w3 = w[(size_t)(k + 3) * MODW];
            const int kk = kb * 128 + k;
            const f32x4 s0 = *(const LAS f32x4*)(sc + kk), s1 = *(const LAS f32x4*)(sc + 2048 + kk), s2 = *(const LAS f32x4*)(sc + 4096 + kk), s3 = *(const LAS f32x4*)(sc + 6144 + kk), s4 = *(const LAS f32x4*)(sc + 8192 + kk);
            a0 += s0[0] * w0 + s0[1] * w1 + s0[2] * w2 + s0[3] * w3;
            a1 += s1[0] * w0 + s1[1] * w1 + s1[2] * w2 + s1[3] * w3;
            a2 += s2[0] * w0 + s2[1] * w1 + s2[2] * w2 + s2[3] * w3;
            a3 += s3[0] * w0 + s3[1] * w1 + s3[2] * w2 + s3[3] * w3;
            a4 += s4[0] * w0 + s4[1] * w1 + s4[2] * w2 + s4[3] * w3;
        }
        if (kb == 0) { const float b = p->ada_b[li * MODW + n]; a0 += b; a1 += b; a2 += b; a3 += b; a4 += b; }
        float* m = p->mod + (size_t)li * 5 * MODW + n;
        unsafeAtomicAdd(m, a0); unsafeAtomicAdd(m + MODW, a1); unsafeAtomicAdd(m + 2 * MODW, a2); unsafeAtomicAdd(m + 3 * MODW, a3); unsafeAtomicAdd(m + 4 * MODW, a4);
    }
    for (int i = blockIdx.x * 512 + tid; i < 4 * 512 * 256 / 8; i += gridDim.x * 512) {
        const float* s = p->cache_k + (size_t)i * 8; const f32x4 a = *(const f32x4*)s, b = *(const f32x4*)(s + 4);
        *(u32x4*)(p->ck + (size_t)i * 8) = pack8u(a, b);
    }
    for (int i = blockIdx.x * 512 + tid; i < 4 * 64 * 256; i += gridDim.x * 512) {
        const int c = i & 255, mb = (i >> 8) & 63, b = i >> 14;
        float v[8];
#pragma unroll
        for (int j = 0; j < 8; ++j) v[j] = p->cache_v[((size_t)(b * 512 + mb * 8 + j)) * 256 + c];
        u32x4 w; w.x = pk2(v[0], v[1]); w.y = pk2(v[2], v[3]); w.z = pk2(v[4], v[5]); w.w = pk2(v[6], v[7]);
        *(u32x4*)(p->cvt + ((size_t)(b * 256 + c)) * 512 + mb * 8) = w;
    }
    cvt_wt<0>(p->even_w_in, nullptr, 3584, p->wt_in0, 2048, 3584, tid);
    cvt_wt<0>(p->even_w_out, nullptr, 2048, p->wt_out0, 2048, 2048, tid);
    cvt_wt<1>(p->ffn_w_gate, p->ffn_w_up, 5632, p->wt_f1a, 2048, 11264, tid);
    cvt_wt<0>(p->ffn_w_down, nullptr, 2048, p->wt_f2a, 5632, 2048, tid);
    cvt_wt<0>(p->ret_w_in, nullptr, 12288, p->wt_in1, 2048, 12288, tid);
    cvt_wt<0>(p->ret_w_out, nullptr, 2048, p->wt_out1, 4096, 2048, tid);
    cvt_wt<1>(p->ffn_w_gate + (size_t)2048 * 5632, p->ffn_w_up + (size_t)2048 * 5632, 5632, p->wt_f1b, 2048, 11264, tid);
    cvt_wt<0>(p->ffn_w_down + (size_t)5632 * 2048, nullptr, 2048, p->wt_f2b, 5632, 2048, tid);
}

__device__ __forceinline__ void norm_phase(const float* xlo, const float* xhi, const float* g, const float* shift, const float* scale, bf16_t* h, int wid, int lane) {
#pragma unroll 2
    for (int row = blockIdx.x * 8 + wid; row < NTOK; row += gridDim.x * 8) {
        const float* xr = (row < TPR ? xlo : xhi) + (size_t)row * DM;
        const int cond = row < TPR ? 0 : 1 + ((row - TPR) >> 10);
        f32x4 v[8]; float ss = 0.f;
#pragma unroll
        for (int i = 0; i < 8; ++i) { v[i] = *(const f32x4*)(xr + i * 256 + lane * 4); ss += v[i][0] * v[i][0] + v[i][1] * v[i][1] + v[i][2] * v[i][2] + v[i][3] * v[i][3]; }
        ss = wave_sum(ss);
        const float rstd = rsqrtf(ss * (1.0f / DM) + EPSN);
#pragma unroll
        for (int i = 0; i < 8; ++i) {
            const int c = i * 256 + lane * 4;
            const f32x4 gg = *(const f32x4*)(g + c), sh = *(const f32x4*)(shift + (size_t)cond * MODW + c), sc = *(const f32x4*)(scale + (size_t)cond * MODW + c);
            const f32x4 o = v[i] * rstd * gg * (1.0f + sc) + sh;
            *(u32x2*)(h + (size_t)row * DM + c) = pack4(o);
        }
    }
}
__device__ __forceinline__ void final_norm_phase(const float* x, const float* g, float* out, int wid, int lane) {
#pragma unroll 2
    for (int row = blockIdx.x * 8 + wid; row < NTOK; row += gridDim.x * 8) {
        const float* xr = x + (size_t)row * DM;
        f32x4 v[8]; float ss = 0.f;
#pragma unroll
        for (int i = 0; i < 8; ++i) { v[i] = *(const f32x4*)(xr + i * 256 + lane * 4); ss += v[i][0] * v[i][0] + v[i][1] * v[i][1] + v[i][2] * v[i][2] + v[i][3] * v[i][3]; }
        ss = wave_sum(ss);
        const float rstd = rsqrtf(ss * (1.0f / DM) + EPSN);
#pragma unroll
        for (int i = 0; i < 8; ++i) { const int c = i * 256 + lane * 4; *(f32x4*)(out + (size_t)row * DM + c) = v[i] * rstd * *(const f32x4*)(g + c); }
    }
}

__device__ __forceinline__ void sgu_phase(ParamsCP p, LAS unsigned char* lds, int tid, int wid, int lane) {
    LAS bf16_t* vnT = (LAS bf16_t*)(lds + 1024);
    const int er = lane & 15, g4 = lane >> 4;
    for (int it = blockIdx.x; it < 512; it += gridDim.x) {
        const int chunk = it >> 3, g = it & 7, tok0 = chunk * 128;
        __syncthreads();
#pragma unroll
        for (int i2 = 0; i2 < 4; ++i2) {
            const int idx = tid + 512 * i2, q = idx >> 4, c8 = (idx & 15) * 8;
            const u32x4 raw = *(const u32x4*)(p->vg0 + (size_t)(tok0 + q) * 1024 + g * 128 + c8);
            const float mu = p->stat[2 * (tok0 + q)] * (1.0f / 1024.0f), rs = rsqrtf(p->stat[2 * (tok0 + q) + 1] * (1.0f / 1024.0f) - mu * mu + EPSN);
            const f32x4 g0 = *(const f32x4*)(p->sgu_ln_g + g * 128 + c8), g1 = *(const f32x4*)(p->sgu_ln_g + g * 128 + c8 + 4);
            const f32x4 b0 = *(const f32x4*)(p->sgu_ln_b + g * 128 + c8), b1 = *(const f32x4*)(p->sgu_ln_b + g * 128 + c8 + 4);
#pragma unroll
            for (int i = 0; i < 4; ++i) {
                const float x0 = (bflo(raw[i]) - mu) * rs, x1 = (bfhi(raw[i]) - mu) * rs;
                const float gg0 = (2 * i < 4) ? g0[(2 * i) & 3] : g1[(2 * i) & 3], gg1 = (2 * i + 1 < 4) ? g0[(2 * i + 1) & 3] : g1[(2 * i + 1) & 3];
                const float bb0 = (2 * i < 4) ? b0[(2 * i) & 3] : b1[(2 * i) & 3], bb1 = (2 * i + 1 < 4) ? b0[(2 * i + 1) & 3] : b1[(2 * i + 1) & 3];
                vnT[(c8 + 2 * i) * 136 + q] = f2bf(x0 * gg0 + bb0);
                vnT[(c8 + 2 * i + 1) * 136 + q] = f2bf(x1 * gg1 + bb1);
            }
        }
        __syncthreads();
        bf16x8 wf[4];
#pragma unroll
        for (int kk = 0; kk < 4; ++kk) { const float* wp = p->sgu_w + ((size_t)(g * 128 + 16 * wid + er)) * 128 + 32 * kk + g4 * 8; wf[kk] = pack8(*(const f32x4*)wp, *(const f32x4*)(wp + 4)); }
        const int tok = tok0 + 16 * wid + er; const float bs = p->sgu_b[g * 128 + 16 * wid + er];
#pragma unroll
        for (int cc = 0; cc < 8; ++cc) {
            f32x4 a = {0.f, 0.f, 0.f, 0.f};
#pragma unroll
            for (int kk = 0; kk < 4; ++kk) { const bf16x8 af = *(const LAS bf16x8*)(vnT + (16 * cc + er) * 136 + 32 * kk + g4 * 8); a = mfma16(af, wf[kk], a); }
            const int c = g * 128 + 16 * cc + g4 * 4;
            const f32x4 uf = unpack4(*(const u32x2*)(p->u0 + (size_t)tok * 1024 + c));
            *(u32x2*)(p->ag + (size_t)tok * 2048 + 1024 + c) = pack4(uf * (a + bs));
        }
    }
}

__device__ __forceinline__ void attn_phase(ParamsCP p, int wid, int lane) {
    const int er = lane & 15, g4 = lane >> 4;
    const float SC = 0.125f * 1.4426950408889634f;
    for (int sl = blockIdx.x * 4 + (wid & 3); sl < 1024; sl += gridDim.x * 4) {
        const bool latent = wid < 4;
        int b, kvh, qt;
        if (latent) { qt = sl & 63; kvh = (sl >> 6) & 3; b = sl >> 8; } else { qt = sl & 15; kvh = (sl >> 4) & 3; b = sl >> 6; }
        const int tokbase = latent ? TPR + b * 1024 : b * 256;
        const int L = latent ? 1024 : 256;
        const int q0 = qt * 16;
        const bf16_t* qp = p->q0 + (size_t)(tokbase + q0 + er) * 1024 + kvh * 256 + g4 * 8;
        bf16x8 qf[4][2]; float m[4], l[4]; f32x4 o[4][4];
#pragma unroll
        for (int g = 0; g < 4; ++g) {
            qf[g][0] = *(const bf16x8*)(qp + g * 64); qf[g][1] = *(const bf16x8*)(qp + g * 64 + 32);
            m[g] = p->attn_sink[kvh * 4 + g] * 1.4426950408889634f; l[g] = g4 == 0 ? 1.0f : 0.0f;
#pragma unroll
            for (int dd = 0; dd < 4; ++dd) o[g][dd] = (f32x4){0.f, 0.f, 0.f, 0.f};
        }
        const int qpos = q0 + er;
        int klo = 0, khi = L;
        if (latent) { klo = (q0 - 128 < 0 ? 0 : q0 - 128) & ~31; khi = (q0 + 16 + 128 + 31) & ~31; if (khi > L) khi = L; }
        const int nloc = (khi - klo) >> 5, ntl = nloc + (latent ? 16 : 0);
        bf16x8 kfn[2][2];
#define ATT_ADDR(TI) \
            const bool loc_ = (TI) < nloc; \
            const int kt_ = loc_ ? klo + (TI) * 32 : ((TI) - nloc) * 32; \
            const bf16_t* kbase_ = loc_ ? p->k0 + (size_t)(tokbase + kt_) * 256 + kvh * 64 : p->ck + (size_t)(b * 512 + kt_) * 256 + kvh * 64; \
            const bf16_t* vbase_ = loc_ ? p->vt0 + (size_t)(kvh * 64) * NTOK + tokbase + kt_ : p->cvt + (size_t)(b * 256 + kvh * 64) * 512 + kt_; \
            const int vstride_ = loc_ ? NTOK : 512;
#define ATT_LOADK(TI) do { ATT_ADDR(TI) (void)vbase_; (void)vstride_; \
            _Pragma("unroll") for (int t = 0; t < 2; ++t) { \
                const bf16_t* kp = kbase_ + (unsigned)((16 * t + er) * 256 + g4 * 8); \
                kfn[t][0] = *(const bf16x8*)kp; kfn[t][1] = *(const bf16x8*)(kp + 32); } \
        } while (0)
        ATT_LOADK(0);
#pragma unroll 1
        for (int ti = 0; ti < ntl; ++ti) {
            const bool loc = ti < nloc;
            const int kt = loc ? klo + ti * 32 : (ti - nloc) * 32;
            const bool mask = loc && latent;
            bf16x8 kf[2][2], vf[4];
#pragma unroll
            for (int t = 0; t < 2; ++t) { kf[t][0] = kfn[t][0]; kf[t][1] = kfn[t][1]; }
            { ATT_ADDR(ti) (void)kbase_;
#pragma unroll
              for (int dd = 0; dd < 4; ++dd) { const bf16_t* vp = vbase_ + (unsigned)((16 * dd + er) * vstride_ + g4 * 4); vf[dd] = cat44(*(const bf16x4*)vp, *(const bf16x4*)(vp + 16)); } }
            if (ti + 1 < ntl) ATT_LOADK(ti + 1);
            float pen[2][4];
#pragma unroll
            for (int t = 0; t < 2; ++t)
#pragma unroll
                for (int j = 0; j < 4; ++j) { const int d = qpos - (kt + 16 * t + g4 * 4 + j); pen[t][j] = (mask && (d > 128 || d < -128)) ? -INFINITY : 0.0f; }
#pragma unroll
            for (int g = 0; g < 4; ++g) {
                f32x4 s[2];
#pragma unroll
                for (int t = 0; t < 2; ++t) {
                    s[t] = mfma16(kf[t][0], qf[g][0], (f32x4){0.f, 0.f, 0.f, 0.f});
                    s[t] = mfma16(kf[t][1], qf[g][1], s[t]);
                }
                float mx = -INFINITY;
#pragma unroll
                for (int t = 0; t < 2; ++t)
#pragma unroll
                    for (int j = 0; j < 4; ++j) { const float v = s[t][j] * SC + pen[t][j]; s[t][j] = v; mx = fmaxf(mx, v); }
                mx = fmaxf(mx, __shfl_xor(mx, 16)); mx = fmaxf(mx, __shfl_xor(mx, 32));
                const float mnew = fmaxf(m[g], mx);
                const float alpha = __builtin_amdgcn_exp2f(m[g] - mnew);
                m[g] = mnew; float lg_ = l[g] * alpha;
#pragma unroll
                for (int dd = 0; dd < 4; ++dd) o[g][dd] *= alpha;
                f32x4 p0, p1;
#pragma unroll
                for (int j = 0; j < 4; ++j) { p0[j] = __builtin_amdgcn_exp2f(s[0][j] - mnew); p1[j] = __builtin_amdgcn_exp2f(s[1][j] - mnew); lg_ += p0[j] + p1[j]; }
                l[g] = lg_;
                const bf16x8 pf = pack8(p0, p1);
#pragma unroll
                for (int dd = 0; dd < 4; ++dd) o[g][dd] = mfma16(vf[dd], pf, o[g][dd]);
            }
        }
#pragma unroll
        for (int g = 0; g < 4; ++g) {
            float lt = l[g]; lt += __shfl_xor(lt, 16); lt += __shfl_xor(lt, 32);
            const float rl = 1.0f / lt;
            bf16_t* op = p->ag + (size_t)(tokbase + q0 + er) * 2048 + (kvh * 4 + g) * 64 + g4 * 4;
#pragma unroll
            for (int dd = 0; dd < 4; ++dd) *(u32x2*)(op + 16 * dd) = pack4(o[g][dd] * rl);
        }
    }
}

__device__ __forceinline__ float logsig(float x) { return -log1pf(__expf(-x)); }
__device__ __forceinline__ bf16x8 scale8(bf16x8 f, const float (&s)[8]) {
    const u32x4 w = __builtin_bit_cast(u32x4, f); u32x4 r;
#pragma unroll
    for (int i = 0; i < 4; ++i) r[i] = pk2(bflo(w[i]) * s[2 * i], bfhi(w[i]) * s[2 * i + 1]);
    return __builtin_bit_cast(bf16x8, r);
}

__device__ __forceinline__ void ret_item(ParamsCP p, LAS unsigned char* lds, int seq, int h, int es, int tid, int wid, int lane) {
    LAS bf16_t* Qs = (LAS bf16_t*)lds; LAS bf16_t* Ks = Qs + 64 * 264; LAS bf16_t* KTs = Ks + 64 * 264; LAS bf16_t* Ps = KTs + 256 * 72;
    const bool sample = seq < 4;
    const int tokbase = sample ? TPR + seq * 1024 : (seq - 4) * 256;
    const int NC = sample ? 16 : 4;
    const int er_ = lane & 15, g4_ = lane >> 4;
    const int e0 = h * 512 + es * 128 + wid * 16;
    const float lgf = logsig(p->ret_dec_f[h]), lgb = logsig(p->ret_dec_b[h]);
    f32x4 S[16];
#pragma unroll 1
    for (int dir = 0; dir < 2; ++dir) {
        const float lg = dir ? lgf : lgb;
        if (sample) {
            const float* st = (dir ? p->st_f : p->st_b) + ((size_t)(seq * 8 + h) * 256) * 512 + es * 128 + wid * 16 + er_;
#pragma unroll
            for (int t = 0; t < 16; ++t)
#pragma unroll
                for (int j = 0; j < 4; ++j) { S[t][j] = st[(size_t)(16 * t + g4_ * 4 + j) * 512]; if (j == 3) __builtin_amdgcn_sched_barrier(0); }
        } else {
#pragma unroll
            for (int t = 0; t < 16; ++t) S[t] = (f32x4){0.f, 0.f, 0.f, 0.f};
        }
        const float gch = __expf(lg * 64.0f);
        u32x4 rq[4], rk[4], rkt[4];
#define RET_LOAD(SIDX) do { \
            const int cc_ = dir ? (SIDX) : NC - 1 - (SIDX), tk_ = tokbase + cc_ * 64; \
            int tv_ = tid, e_ = er_, g_ = g4_; asm volatile("" : "+v"(tv_), "+v"(e_), "+v"(g_)); \
            const bf16_t* qb_ = p->q1 + (size_t)tk_ * 2048 + h * 256; \
            const bf16_t* kb_ = p->k1 + (size_t)tk_ * 2048 + h * 256; \
            const bf16_t* ktb_ = p->kt1 + (size_t)(h * 256) * NTOK + tk_; \
            _Pragma("unroll") for (int i2 = 0; i2 < 4; ++i2) { \
                const int idx = tv_ + 512 * i2; \
                { const int r = idx >> 5, c8 = (idx & 31) * 8; \
                  rq[i2] = *(const u32x4*)(qb_ + (unsigned)(r * 2048 + c8)); \
                  if (dir) rk[i2] = *(const u32x4*)(kb_ + (unsigned)(r * 2048 + c8)); } \
                { const int r = idx >> 3, c8 = (idx & 7) * 8; \
                  rkt[i2] = *(const u32x4*)(ktb_ + (unsigned)(r * NTOK + c8)); } \
            } \
        } while (0)
        RET_LOAD(0);
#pragma unroll 1
        for (int s = 0; s < NC; ++s) {
            const int cc = dir ? s : NC - 1 - s, tok0 = tokbase + cc * 64;
            int tidv = tid, er = er_, g4 = g4_; asm volatile("" : "+v"(tidv), "+v"(er), "+v"(g4));
            bf16_t* ob = p->o1 + (size_t)tok0 * 4096 + e0;
            __syncthreads();
#pragma unroll
            for (int i2 = 0; i2 < 4; ++i2) {
                const int idx = tidv + 512 * i2;
                { const int r = idx >> 5, c8 = (idx & 31) * 8;
                  *(LAS u32x4*)(Qs + r * 264 + c8) = rq[i2];
                  if (dir) *(LAS u32x4*)(Ks + r * 264 + c8) = rk[i2]; }
                { const int r = idx >> 3, c8 = (idx & 7) * 8;
                  *(LAS u32x4*)(KTs + r * 72 + c8) = rkt[i2]; }
            }
            bf16x8 vf[2]; u32x2 obc[4];
            { const bf16_t* vtb = p->vt1 + (size_t)e0 * NTOK + tok0;
#pragma unroll
              for (int kk = 0; kk < 2; ++kk) vf[kk] = *(const bf16x8*)(vtb + (unsigned)(er * NTOK + 32 * kk + g4 * 8));
              if (dir) {
#pragma unroll
                  for (int is = 0; is < 4; ++is) obc[is] = *(const u32x2*)(ob + (unsigned)((16 * is + er) * 4096 + g4 * 4));
              } }
            asm volatile("s_waitcnt lgkmcnt(0)" ::: "memory"); __builtin_amdgcn_s_barrier(); asm volatile("" ::: "memory");
            if (s + 1 < NC) RET_LOAD(s + 1);
            if (dir) {
#pragma unroll
                for (int pi2 = 0; pi2 < 2; ++pi2) {
                    const int pi = 2 * wid + pi2, js = pi >> 2, is = pi & 3;
                    f32x4 a = {0.f, 0.f, 0.f, 0.f};
#pragma unroll
                    for (int hb = 0; hb < 2; ++hb) {
                        bf16x8 kf[4], qf[4];
#pragma unroll
                        for (int u = 0; u < 4; ++u) {
                            kf[u] = *(const LAS bf16x8*)(Ks + (16 * js + er) * 264 + 32 * (4 * hb + u) + g4 * 8);
                            qf[u] = *(const LAS bf16x8*)(Qs + (16 * is + er) * 264 + 32 * (4 * hb + u) + g4 * 8);
                        }
                        asm volatile("" ::: "memory");
#pragma unroll
                        for (int u = 0; u < 4; ++u) a = mfma16(kf[u], qf[u], a);
                        __builtin_amdgcn_sched_group_barrier(0x100, 8, 0); __builtin_amdgcn_sched_group_barrier(0x008, 4, 0);
                    }
                    const int i = 16 * is + er;
#pragma unroll
                    for (int j4 = 0; j4 < 4; ++j4) {
                        const int j = 16 * js + g4 * 4 + j4, dd = i - j;
                        const float dv = dd > 0 ? __expf(lgf * (float)dd) : (dd < 0 ? __expf(lgb * (float)(-dd)) : 2.0f);
                        a[j4] *= dv;
                    }
                    *(LAS u32x2*)(Ps + i * 72 + 16 * js + g4 * 4) = pack4(a);
                }
                asm volatile("s_waitcnt lgkmcnt(0)" ::: "memory"); __builtin_amdgcn_s_barrier(); asm volatile("" ::: "memory");
            }
            f32x4 a2[4];
#pragma unroll
            for (int is = 0; is < 4; ++is) a2[is] = (f32x4){0.f, 0.f, 0.f, 0.f};
#pragma unroll
            for (int s8 = 0; s8 < 8; ++s8) {
                bf16x8 qf[4];
#pragma unroll
                for (int is = 0; is < 4; ++is) {
                    const LAS bf16_t* qp = Qs + (16 * is + er) * 264 + 32 * s8 + g4 * 4;
                    qf[is] = cat44(*(const LAS bf16x4*)qp, *(const LAS bf16x4*)(qp + 16));
                }
                const bf16x8 sf = pack8(S[2 * s8], S[2 * s8 + 1]);
#pragma unroll
                for (int is = 0; is < 4; ++is) a2[is] = mfma16(sf, qf[is], a2[is]);
                __builtin_amdgcn_sched_group_barrier(0x100, 4, 0); __builtin_amdgcn_sched_group_barrier(0x008, 4, 0);
            }
#pragma unroll
            for (int ip = 0; ip < 2; ++ip) {
                bf16x8 pfr[2][2];
                if (dir) {
#pragma unroll
                    for (int u = 0; u < 2; ++u)
#pragma unroll
                        for (int kk = 0; kk < 2; ++kk) pfr[u][kk] = *(const LAS bf16x8*)(Ps + (16 * (2 * ip + u) + er) * 72 + 32 * kk + g4 * 8);
                }
#pragma unroll
                for (int u = 0; u < 2; ++u) {
                    const int is = 2 * ip + u;
                    f32x4 o = a2[is] * __expf(lg * (float)(dir ? 16 * is + er + 1 : 64 - 16 * is - er));
                    bf16_t* op = ob + (unsigned)((16 * is + er) * 4096 + g4 * 4);
                    if (dir) {
                        f32x4 a1 = {0.f, 0.f, 0.f, 0.f};
#pragma unroll
                        for (int kk = 0; kk < 2; ++kk) a1 = mfma16(vf[kk], pfr[u][kk], a1);
                        o += a1; o += unpack4(obc[is]);
                    }
                    *(u32x2*)op = pack4(o);
                }
            }
            bf16x8 vs[2];
#pragma unroll
            for (int kk = 0; kk < 2; ++kk) {
                float fu[8];
#pragma unroll
                for (int i = 0; i < 8; ++i) { const int j = 32 * kk + g4 * 8 + i; fu[i] = __expf(lg * (float)(dir ? 63 - j : j)); }
                vs[kk] = scale8(vf[kk], fu);
            }

#pragma unroll
            for (int tg = 0; tg < 8; ++tg) {
                bf16x8 af[2][2];
#pragma unroll
                for (int u = 0; u < 2; ++u)
#pragma unroll
                    for (int kk = 0; kk < 2; ++kk) af[u][kk] = *(const LAS bf16x8*)(KTs + (16 * (2 * tg + u) + er) * 72 + 32 * kk + g4 * 8);
#pragma unroll
                for (int u = 0; u < 2; ++u) {
                    S[2 * tg + u] *= gch;
#pragma unroll
                    for (int kk = 0; kk < 2; ++kk) S[2 * tg + u] = mfma16(af[u][kk], vs[kk], S[2 * tg + u]);
                }
                __builtin_amdgcn_sched_group_barrier(0x100, 4, 0); __builtin_amdgcn_sched_group_barrier(0x008, 4, 0);
            }
        }
        if (!sample) {
            float* so = p->out + (dir ? (size_t)18874368 : (size_t)35651584) + ((size_t)((seq - 4) * 8 + h) * 256) * 512 + es * 128 + wid * 16 + er_;
#pragma unroll
            for (int t = 0; t < 16; ++t)
#pragma unroll
                for (int j = 0; j < 4; ++j) { so[(size_t)(16 * t + g4_ * 4 + j) * 512] = S[t][j]; if (j == 3) __builtin_amdgcn_sched_barrier(0); }
        }
    }
}

__device__ __forceinline__ void ret_phase(ParamsCP p, LAS unsigned char* lds, int tid, int wid, int lane) {
    for (int slot = blockIdx.x; slot < 256; slot += gridDim.x) {
        if (slot < 128) { ret_item(p, lds, slot >> 5, (slot >> 2) & 7, slot & 3, tid, wid, lane); }
        else {
#pragma unroll 1
            for (int k = 0; k < 4; ++k) { const int j = (slot - 128) * 4 + k; ret_item(p, lds, 4 + (j >> 5), (j >> 2) & 7, j & 3, tid, wid, lane); }
        }
    }
}

__device__ __forceinline__ void gn_phase(ParamsCP p, int wid, int lane) {
#pragma unroll 4
    for (int pr = blockIdx.x * 8 + wid; pr < NTOK * 8; pr += gridDim.x * 8) {
        const int tok = pr >> 3, h = pr & 7;
        const size_t base = (size_t)tok * 4096 + h * 512 + lane * 8;
        const u32x4 raw = *(const u32x4*)(p->o1 + base);
        float x[8]; float s = 0.f, ss = 0.f;
#pragma unroll
        for (int i = 0; i < 4; ++i) { x[2 * i] = bflo(raw[i]); x[2 * i + 1] = bfhi(raw[i]); s += x[2 * i] + x[2 * i + 1]; ss += x[2 * i] * x[2 * i] + x[2 * i + 1] * x[2 * i + 1]; }
        s = wave_sum(s); ss = wave_sum(ss);
        const float mu = s * (1.0f / 512.0f), var = ss * (1.0f / 512.0f) - mu * mu, rs = rsqrtf(var + EPSN);
        const f32x4 g0 = *(const f32x4*)(p->ret_gn_g + h * 512 + lane * 8), g1 = *(const f32x4*)(p->ret_gn_g + h * 512 + lane * 8 + 4);
        const u32x4 sg = *(const u32x4*)(p->sg1 + base);
        f32x4 o0, o1;
#pragma unroll
        for (int i = 0; i < 2; ++i) {
            o0[2 * i] = (x[2 * i] - mu) * rs * g0[2 * i] * bflo(sg[i]); o0[2 * i + 1] = (x[2 * i + 1] - mu) * rs * g0[2 * i + 1] * bfhi(sg[i]);
            o1[2 * i] = (x[4 + 2 * i] - mu) * rs * g1[2 * i] * bflo(sg[2 + i]); o1[2 * i + 1] = (x[4 + 2 * i + 1] - mu) * rs * g1[2 * i + 1] * bfhi(sg[2 + i]);
        }
        *(u32x4*)(p->a2 + base) = pack8u(o0, o1);
    }
}

#define XB_TMO      128
#define XB_XCNT(j)  (256  + 64 * (j))
#define XB_XSUB(j)  (1280 + 64 * (j))
#define XB_XGEN(j)  (2304 + 64 * (j))
#define XB_TOP      3328
#define XB_TOPGEN   3392
#define XCD_BAR_WORDS 3456
#define XB_SPIN_CAP (1u << 18)

__device__ __forceinline__ unsigned xb_ld(unsigned* p)              { return __hip_atomic_load(p, __ATOMIC_RELAXED, __HIP_MEMORY_SCOPE_AGENT); }
__device__ __forceinline__ unsigned xb_add(unsigned* p, unsigned v) { return __hip_atomic_fetch_add(p, v, __ATOMIC_RELAXED, __HIP_MEMORY_SCOPE_AGENT); }
__device__ __forceinline__ unsigned xb_xcc_id() { return (unsigned)__builtin_amdgcn_s_getreg((3 << 11) | 20) & 0xFu; }
#define XB_SPIN(cond, bar) do { unsigned _sp = 0; while (cond) { __builtin_amdgcn_s_sleep(1); \
    if ((++_sp & 255u) == 0u) { if (xb_ld(&(bar)[XB_TMO])) break; if (_sp > XB_SPIN_CAP) { atomicAdd(&(bar)[XB_TMO], 1u); break; } } } } while (0)

struct XcdBarrier {
    unsigned* bar; unsigned x;
    volatile LAS unsigned* st;
};

__device__ __forceinline__ XcdBarrier xcd_barrier_post(unsigned* bar, volatile LAS unsigned* st) {
    XcdBarrier b; b.bar = bar; b.x = xb_xcc_id(); b.st = st;
    if (threadIdx.x == 0) (void)xb_add(&bar[XB_XCNT(b.x)], 1u);
    return b;
}
__device__ __forceinline__ void xcd_barrier_complete(unsigned* bar, unsigned x, unsigned& nloc, unsigned& nx) {
    const unsigned G = gridDim.x * gridDim.y * gridDim.z;
    unsigned sum, cnt, mine, sp = 0u;
    for (;;) {
        sum = 0u; cnt = 0u; mine = 0u;
#pragma unroll
        for (unsigned j = 0; j < 16; ++j) { const unsigned c = xb_ld(&bar[XB_XCNT(j)]); sum += c; cnt += (c > 0u) ? 1u : 0u; mine = (j == x) ? c : mine; }
        if (sum == G) break;
        __builtin_amdgcn_s_sleep(1);
        if ((++sp & 255u) == 0u) { if (xb_ld(&bar[XB_TMO])) break; if (sp > XB_SPIN_CAP) { atomicAdd(&bar[XB_TMO], 1u); break; } }
    }
    nloc = mine > 0u ? mine : 1u; nx = cnt > 0u ? cnt : 1u;
}

__device__ __forceinline__ void xcd_barrier(const XcdBarrier& b) {
    asm volatile("s_waitcnt vmcnt(0)" ::: "memory");
    __syncthreads();
    if (threadIdx.x == 0) {
        unsigned* bar = b.bar;
        __builtin_amdgcn_s_waitcnt(0);
        unsigned nloc = b.st[0], nx = b.st[1];
        if (nloc == 0u) { xcd_barrier_complete(bar, b.x, nloc, nx); b.st[0] = nloc; b.st[1] = nx; }
        const unsigned old = xb_add(&bar[XB_XSUB(b.x)], 1u);
        const unsigned gen = old / nloc;
        if (old + 1u == (gen + 1u) * nloc) {
            __builtin_amdgcn_fence(__ATOMIC_RELEASE, "agent");
            asm volatile("s_waitcnt vmcnt(0)" ::: "memory");
            const unsigned og = xb_add(&bar[XB_TOP], 1u);
            const unsigned tg = og / nx;
            if (og + 1u == (tg + 1u) * nx) xb_add(&bar[XB_TOPGEN], 1u);
            else XB_SPIN(xb_ld(&bar[XB_TOPGEN]) == tg, bar);
            __builtin_amdgcn_fence(__ATOMIC_ACQUIRE, "agent");
            xb_add(&bar[XB_XGEN(b.x)], 1u);
            asm volatile("s_waitcnt vmcnt(0)" ::: "memory");
        } else {
            XB_SPIN(xb_ld(&bar[XB_XGEN(b.x)]) == gen, bar);
            __builtin_amdgcn_fence(__ATOMIC_ACQUIRE, "agent");
            asm volatile("s_waitcnt vmcnt(0)" ::: "memory");
        }
    }
    __syncthreads();
}

constexpr int NPHASE = 17;
__global__ void __launch_bounds__(512, 2) fwd_megakernel(Params p_unused, int ph_lo, int ph_hi) {
    extern __shared__ __attribute__((aligned(16))) unsigned char shm[];
    LAS unsigned char* lds = (LAS unsigned char*)shm;
    cg::grid_group grid = cg::this_grid();
    const int tid0 = threadIdx.x;
    volatile LAS unsigned* xst = (volatile LAS unsigned*)(lds + 131072);
    if (tid0 < 4) xst[tid0] = 0u;
    __syncthreads();
    { ParamsCP p0 = (ParamsCP)__builtin_amdgcn_kernarg_segment_ptr(); (void)xcd_barrier_post(p0->bar, xst); }
    if (ph_hi < 0) grid.sync();
#pragma unroll 1
    for (int ph = ph_lo; ph < ph_hi; ++ph) {
        if (ph > ph_lo) {
            ParamsCP pb = (ParamsCP)__builtin_amdgcn_kernarg_segment_ptr(); asm volatile("" : "+s"(pb));
            XcdBarrier xb; xb.bar = pb->bar; xb.x = xb_xcc_id(); xb.st = (volatile LAS unsigned*)(lds + 131072);
            xcd_barrier(xb);
#if defined(PROBE_DOUBLE_SYNC)
            xcd_barrier(xb);
#endif
        }
        int kind, L = 0;
        if (ph == 0) kind = 0;
        else if (ph == 16) kind = 11;
        else if (ph <= 7) { L = 0; const int k = ph - 1; kind = k == 0 ? 1 : k == 1 ? 2 : k == 2 ? 3 : k == 3 ? 4 : k == 4 ? 5 : k == 5 ? 6 : 7; }
        else { L = 1; const int k = ph - 8; kind = k == 0 ? 1 : k == 1 ? 8 : k == 2 ? 9 : k == 3 ? 10 : k == 4 ? 4 : k == 5 ? 5 : k == 6 ? 6 : 7; }
#ifndef PH_MASK
#define PH_MASK 0xfff
#endif
        if (!((PH_MASK >> kind) & 1)) continue;
#if defined(PROBE_REP_NONGEMM)
        const int nrep = ((PROBE_REP_NONGEMM >> kind) & 1) ? 2 : 1;
#else
        const int nrep = 1;
#endif
#pragma unroll 1
        for (int rep = 0; rep < nrep; ++rep) {
        if (rep) __syncthreads();
        int tid = tid0; asm volatile("" : "+v"(tid));
        ParamsCP p = (ParamsCP)__builtin_amdgcn_kernarg_segment_ptr(); asm volatile("" : "+s"(p));
        const int wid = __builtin_amdgcn_readfirstlane(tid >> 6), lane = tid & 63;
        const float* modL = p->mod + (size_t)L * 5 * MODW;
        switch (kind) {
        case 0: phase0(p, lds, tid, rep == 0); break;
        case 1: {
            const float* xlo = L == 0 ? p->x_prompt : p->xb; const float* xhi = L == 0 ? p->x_sample - (size_t)TPR * DM : p->xb;
            norm_phase(xlo, xhi, p->norm_mix_g + L * DM, modL, modL + 2048, p->h, wid, lane);
        } break;
        case 2: { EpiInProj0 E; E.q = p->q0; E.k = p->k0; E.vt = p->vt0; E.u = p->u0; E.vg = p->vg0; E.outk = p->out + 16777216; E.outv = p->out + 17825792; E.stat = p->stat;
                  run_gemm(lds, p->h, p->wt_in0, 3584, 2048, E); } break;
        case 3: sgu_phase(p, lds, tid, wid, lane); attn_phase(p, wid, lane); break;
        case 4: case 7: {
            EpiResid E; const bf16_t *A, *Bt; int K;
            if (kind == 4) {
                if (L == 0) { A = p->ag; Bt = p->wt_out0; K = 2048; E.res_lo = p->x_prompt; E.res_hi = p->x_sample - (size_t)TPR * DM; }
                else { A = p->a2; Bt = p->wt_out1; K = 4096; E.res_lo = p->xb; E.res_hi = p->xb; }
                E.gate = modL + 4096; E.out = p->xa;
            } else { A = p->act; Bt = L == 0 ? p->wt_f2a : p->wt_f2b; K = 5632; E.res_lo = p->xa; E.res_hi = p->xa; E.gate = modL + 10240; E.out = p->xb; }
            run_gemm(lds, A, Bt, 2048, K, E);
        } break;
        case 5: norm_phase(p->xa, p->xa, p->norm_ffn_g + L * DM, modL + 6144, modL + 8192, p->h, wid, lane); break;
        case 6: { EpiSwiGLU E; E.act = p->act; run_gemm(lds, p->h, L == 0 ? p->wt_f1a : p->wt_f1b, 11264, 2048, E); } break;
        case 8: { EpiRetIn E; E.q1 = p->q1; E.k1 = p->k1; E.sg1 = p->sg1; E.kt1 = p->kt1; E.vt1 = p->vt1; run_gemm(lds, p->h, p->wt_in1, 12288, 2048, E); } break;
        case 9: ret_phase(p, lds, tid, wid, lane); break;
        case 10: gn_phase(p, wid, lane); break;
        default: final_norm_phase(p->xb, p->final_g, p->out, wid, lane); break;
        }
        }
    }
}

extern "C" void kernel_launch(void* const* d_in, const int* in_sizes, int n_in, void* d_out, int out_size, void* d_ws, size_t ws_size, hipStream_t stream) {
    (void)in_sizes; (void)n_in; (void)out_size; (void)ws_size;
    static int grid_blocks = 0;
    if (!grid_blocks) {
        hipFuncSetAttribute((const void*)fwd_megakernel, hipFuncAttributeMaxDynamicSharedMemorySize, LDS_BYTES);
        int dev = 0, cus = 0, per_cu = 0;
        hipGetDevice(&dev);
        hipDeviceGetAttribute(&cus, hipDeviceAttributeMultiprocessorCount, dev);
        hipOccupancyMaxActiveBlocksPerMultiprocessor(&per_cu, fwd_megakernel, 512, LDS_BYTES);
        if (per_cu < 1) per_cu = 1;
        if (per_cu > 1) per_cu = 1;
        grid_blocks = cus * per_cu;
    }
    Params hp;
    memset(&hp, 0, sizeof(hp));
    const float* const* in = (const float* const*)d_in;
    hp.x_prompt = in[0]; hp.x_sample = in[1]; hp.cache_k = in[2]; hp.cache_v = in[3]; hp.st_f = in[4]; hp.st_b = in[5]; hp.c = in[6]; hp.c_ctx = in[7];
    hp.ada_w = in[8]; hp.ada_b = in[9]; hp.norm_mix_g = in[10]; hp.norm_ffn_g = in[11]; hp.even_w_in = in[12]; hp.even_w_out = in[13]; hp.attn_sink = in[14];
    hp.sgu_ln_g = in[15]; hp.sgu_ln_b = in[16]; hp.sgu_w = in[17]; hp.sgu_b = in[18]; hp.ret_w_in = in[19]; hp.ret_w_out = in[20]; hp.ret_gn_g = in[21];
    hp.ret_dec_f = in[22]; hp.ret_dec_b = in[23]; hp.ffn_w_gate = in[24]; hp.ffn_w_up = in[25]; hp.ffn_w_down = in[26]; hp.final_g = in[27];
    hp.out = (float*)d_out;
    unsigned char* w = (unsigned char*)d_ws; size_t off = 0;
    auto take = [&](size_t bytes) { unsigned char* r = w + off; off += (bytes + 255) & ~(size_t)255; return r; };
    hp.wt_in0 = (bf16_t*)take((size_t)3584 * 2048 * 2); hp.wt_out0 = (bf16_t*)take((size_t)2048 * 2048 * 2);
    hp.wt_f1a = (bf16_t*)take((size_t)11264 * 2048 * 2); hp.wt_f1b = (bf16_t*)take((size_t)11264 * 2048 * 2);
    hp.wt_f2a = (bf16_t*)take((size_t)2048 * 5632 * 2); hp.wt_f2b = (bf16_t*)take((size_t)2048 * 5632 * 2);
    hp.wt_in1 = (bf16_t*)take((size_t)12288 * 2048 * 2); hp.wt_out1 = (bf16_t*)take((size_t)2048 * 4096 * 2);
    hp.mod = (float*)take((size_t)2 * 5 * MODW * 4); hp.stat = (float*)take((size_t)NTOK * 2 * 4); hp.bar = (unsigned*)take((size_t)XCD_BAR_WORDS * 4);
    hp.h = (bf16_t*)take((size_t)NTOK * DM * 2);
    hp.xa = (float*)take((size_t)NTOK * DM * 4); hp.xb = (float*)take((size_t)NTOK * DM * 4);
    hp.act = (bf16_t*)take((size_t)NTOK * 5632 * 2); hp.a2 = hp.act;
    hp.o1 = (bf16_t*)take((size_t)NTOK * 4096 * 2);
    unsigned char* ra = w + off; const size_t ra_off = off;
    hp.q1 = (bf16_t*)take((size_t)NTOK * 2048 * 2); hp.k1 = (bf16_t*)take((size_t)NTOK * 2048 * 2); hp.sg1 = (bf16_t*)take((size_t)NTOK * 4096 * 2);
    hp.kt1 = (bf16_t*)take((size_t)2048 * NTOK * 2); hp.vt1 = (bf16_t*)take((size_t)4096 * NTOK * 2);
    off = ra_off; (void)ra;
    hp.q0 = (bf16_t*)take((size_t)NTOK * 1024 * 2); hp.k0 = (bf16_t*)take((size_t)NTOK * 256 * 2); hp.vt0 = (bf16_t*)take((size_t)256 * NTOK * 2);
    hp.u0 = (bf16_t*)take((size_t)NTOK * 1024 * 2); hp.vg0 = (bf16_t*)take((size_t)NTOK * 1024 * 2);
    hp.ck = (bf16_t*)take((size_t)4 * 512 * 256 * 2); hp.cvt = (bf16_t*)take((size_t)4 * 256 * 512 * 2); hp.ag = (bf16_t*)take((size_t)NTOK * 2048 * 2);
    hipMemsetAsync(hp.mod, 0, (size_t)2 * 5 * MODW * 4 + (size_t)NTOK * 2 * 4 + (size_t)XCD_BAR_WORDS * 4, stream);
#if defined(MK_MULTI)
    for (int ph = 0; ph < NPHASE; ++ph) hipLaunchKernelGGL(fwd_megakernel, dim3(grid_blocks), dim3(512), LDS_BYTES, stream, hp, ph, ph + 1);
#else
    int lo = 0, hi = NPHASE;
    void* args[] = {&hp, &lo, &hi};
    hipError_t e = hipLaunchCooperativeKernel((void*)fwd_megakernel, dim3(grid_blocks), dim3(512), args, LDS_BYTES, stream);
    if (e != hipSuccess) fprintf(stderr, "cooperative launch failed: %s (grid %d)\n", hipGetErrorString(e), grid_blocks);
#endif
}
```

```cpp
#include <hip/hip_runtime.h>
#include <hip/hip_cooperative_groups.h>
#include <cstdio>
#include <cstring>
#include <cmath>

namespace pg8 {
#define PG8_LAS __attribute__((address_space(3)))
typedef unsigned short bf16_t;
typedef short bf16x8 __attribute__((ext_vector_type(8)));
typedef float f32x4 __attribute__((ext_vector_type(4)));
typedef unsigned u32x4 __attribute__((ext_vector_type(4)));
constexpr int BM = 256, BK = 64, HALF = 128, HTB = HALF * BK * 2  , STAGE_BYTES = 8 * HTB, NXCD = 8, WGM = 8;

__host__ __device__ __forceinline__ int lds_byte(int r, int c) { const int st = (r >> 4) * 2 + (c >> 5), rr = r & 15, cc = c & 31, ob = rr * 64 + cc * 2; return st * 1024 + (ob ^ (((ob >> 9) & 1) << 5)); }
__host__ __device__ __forceinline__ void stage_rc(int b, int& R, int& C) { const int st = b / 1024, sb = b % 1024, swz = sb ^ (((sb >> 9) & 1) << 5); R = (st >> 1) * 16 + swz / 64; C = (st & 1) * 32 + (swz % 64) / 2; }
__host__ __device__ __forceinline__ int perm32(int rho) { const int n = rho >> 4, i = rho & 15; return 8 * (i >> 2) + 4 * n + (i & 3); }

struct Unit { int pm, pn; };
struct Gemm { const bf16_t* A; const bf16_t* Bt; int M, N, K; };

struct StaticOrder {
    int nM, nN, nwg, G, c;
    __host__ __device__ void init(int M, int N, int G_, int c_) { nM = M / BM; nN = N / BM; nwg = nM * nN; G = G_; c = c_; }
    __host__ __device__ bool next(int i, Unit& u) const {
        const long L = (long)i * G + c; if (L >= nwg) return false;
        int wgid = (int)L; { const int q = nwg / NXCD, r = nwg % NXCD, xcd = wgid % NXCD, off = wgid / NXCD; wgid = (xcd < r ? xcd * (q + 1) : r * (q + 1) + (xcd - r) * q) + off; }
        const int nig = WGM * nN, gid = wgid / nig, fm = gid * WGM, gsz = (nM - fm) < WGM ? (nM - fm) : WGM;
        u.pm = fm + ((wgid % nig) % gsz); u.pn = (wgid % nig) / gsz; return true;
    }
    __device__ __forceinline__ void a_ready(const Unit&) const {}
    __device__ __forceinline__ void done(const Unit&) const {}
};
template <class Epi, class Sched, bool STAMP = false>
__device__ __forceinline__ void gemm_phase(PG8_LAS unsigned char* lds, const Gemm g, const Sched& S, const Epi& E, unsigned long long* stamps) {
    const int tid = threadIdx.x, wid = __builtin_amdgcn_readfirstlane(tid >> 6), lane = tid & 63, wr = wid >> 2, wc = wid & 3, fr = lane & 15, fq = lane >> 4;
    const int K = g.K, nt = K / BK;
    int ts_lo = 0, ts_hi = 0, nts = 0; const unsigned long long rt_entry = STAMP ? (unsigned long long)wall_clock64() : 0ull;
#define PG8_STAMP() do { if (STAMP && wid == 0 && nts < 64) { const unsigned long long _c = (unsigned long long)clock64(); \
        ts_lo = (lane == nts) ? (int)(unsigned)_c : ts_lo; ts_hi = (lane == nts) ? (int)(unsigned)(_c >> 32) : ts_hi; ++nts; } } while (0)
    PG8_STAMP();
    unsigned voffA[2], voffB[2];
#pragma unroll
    for (int i = 0; i < 2; ++i) { int R, C; stage_rc(tid * 16 + i * 8192, R, C); const int Rb = Epi::PERM ? ((R & ~31) + perm32(R & 31)) : R;
        voffA[i] = (unsigned)(R * K + C) * 2u; voffB[i] = (unsigned)(Rb * K + C) * 2u; }
    const size_t kstep = (size_t)(BK * 2);
    const size_t hstep = (size_t)HALF * K * 2;
    const size_t tstep = 2 * hstep;
    const unsigned ldsw = (unsigned)wid * 1024u;
    const int aoff = lds_byte(wr * 64 + fr, fq * 8), boff = lds_byte(wc * 32 + fr, fq * 8);
#define PG8_SA(b, h) (((b) * 2 + (h)) * HTB)
#define PG8_SB(b, h) ((4 + (b) * 2 + (h)) * HTB)
#define PG8_STAGE(bufoff, gbase, voff) do { _Pragma("unroll") for (int _i = 0; _i < 2; ++_i) \
        __builtin_amdgcn_global_load_lds((const unsigned*)((const char*)(gbase) + (voff)[_i]), (PG8_LAS unsigned*)(lds + (bufoff) + ldsw + _i * 8192), 16, 0, 0); } while (0)
#define PG8_LDA(dst, b, h) do { _Pragma("unroll") for (int m = 0; m < 4; ++m) _Pragma("unroll") for (int k = 0; k < 2; ++k) dst[m][k] = *(const PG8_LAS bf16x8*)(lds + PG8_SA(b, h) + aoff + m * 2048 + k * 1024); } while (0)
#define PG8_LDB(dst, b, h) do { _Pragma("unroll") for (int n = 0; n < 2; ++n) _Pragma("unroll") for (int k = 0; k < 2; ++k) dst[n][k] = *(const PG8_LAS bf16x8*)(lds + PG8_SB(b, h) + boff + n * 2048 + k * 1024); } while (0)
#define PG8_MMA(ai, bj, At, Bt) do { __builtin_amdgcn_s_setprio(1); _Pragma("unroll") for (int m = 0; m < 4; ++m) _Pragma("unroll") for (int n = 0; n < 2; ++n) _Pragma("unroll") for (int k = 0; k < 2; ++k) \
        acc[ai][bj][m][n] = __builtin_amdgcn_mfma_f32_16x16x32_bf16(Bt[n][k], At[m][k], acc[ai][bj][m][n], 0, 0, 0); __builtin_amdgcn_s_setprio(0); } while (0)
#define PG8_WAIT_V(n) asm volatile("s_waitcnt vmcnt(" #n ")" ::: "memory")
#define PG8_WAIT_L(n) asm volatile("s_waitcnt lgkmcnt(" #n ")" ::: "memory")
#define PG8_BAR __builtin_amdgcn_s_barrier()
#define PG8_SCHED __builtin_amdgcn_sched_barrier(0)
    Unit cur, nxt; int ui = 0;
    if (!S.next(0, cur)) return;
    f32x4 acc[2][2][4][2];
#pragma unroll
    for (int a = 0; a < 2; ++a)
#pragma unroll
        for (int b = 0; b < 2; ++b)
#pragma unroll
            for (int m = 0; m < 4; ++m)
#pragma unroll
                for (int n = 0; n < 2; ++n) acc[a][b][m][n] = (f32x4){0.f, 0.f, 0.f, 0.f};
    bf16x8 At[4][2], B0[2][2], B1[2][2];
    const char* cA = (const char*)g.A + (size_t)cur.pm * tstep; const char* cB = (const char*)g.Bt + (size_t)cur.pn * tstep;
    S.a_ready(cur);
    PG8_STAGE(PG8_SB(0, 0), cB, voffB); PG8_STAGE(PG8_SA(0, 0), cA, voffA); PG8_STAGE(PG8_SB(0, 1), cB + hstep, voffB); PG8_STAGE(PG8_SA(0, 1), cA + hstep, voffA);
    if (wr == 1) PG8_BAR;
    PG8_WAIT_V(4); PG8_BAR;
    PG8_STAGE(PG8_SB(1, 0), cB + kstep, voffB); PG8_STAGE(PG8_SA(1, 0), cA + kstep, voffA); PG8_STAGE(PG8_SB(1, 1), cB + hstep + kstep, voffB);
    PG8_WAIT_V(6); PG8_BAR;
    PG8_STAMP();
    for (;;) {
        const bool has_next = S.next(ui + 1, nxt);
        const char* nA = has_next ? (const char*)g.A + (size_t)nxt.pm * tstep : cA; const char* nB = has_next ? (const char*)g.Bt + (size_t)nxt.pn * tstep : cB;
        for (int t = 0; t < nt; t += 2) {
            const bool last = (t == nt - 2);
            const char* a1 = cA + (size_t)(t + 1) * kstep;
            const char* a2 = last ? nA : cA + (size_t)(t + 2) * kstep; const char* b2 = last ? nB : cB + (size_t)(t + 2) * kstep;
            const char* a3 = a2 + kstep; const char* b3 = b2 + kstep;
            if (last && has_next) S.a_ready(nxt);
            PG8_LDB(B0, 0, 0); PG8_SCHED; PG8_LDA(At, 0, 0); PG8_STAGE(PG8_SA(1, 1), a1 + hstep, voffA);
            PG8_WAIT_L(8); PG8_BAR; PG8_WAIT_L(0); PG8_MMA(0, 0, At, B0); PG8_BAR; PG8_SCHED;
            PG8_LDB(B1, 0, 1); PG8_STAGE(PG8_SB(0, 0), b2, voffB);
            PG8_BAR; PG8_WAIT_L(0); PG8_MMA(0, 1, At, B1); PG8_BAR;
            PG8_LDA(At, 0, 1); PG8_STAGE(PG8_SA(0, 0), a2, voffA);
            PG8_BAR; PG8_WAIT_L(0); PG8_MMA(1, 0, At, B0); PG8_BAR; PG8_SCHED;
            PG8_STAGE(PG8_SB(0, 1), b2 + hstep, voffB);
            PG8_WAIT_V(6); PG8_BAR; PG8_MMA(1, 1, At, B1); PG8_BAR;
            PG8_LDB(B0, 1, 0); PG8_SCHED; PG8_LDA(At, 1, 0); PG8_STAGE(PG8_SA(0, 1), a2 + hstep, voffA);
            PG8_WAIT_L(8); PG8_BAR; PG8_WAIT_L(0); PG8_MMA(0, 0, At, B0); PG8_BAR; PG8_SCHED;
            PG8_LDB(B1, 1, 1); PG8_STAGE(PG8_SB(1, 0), b3, voffB);
            PG8_BAR; PG8_WAIT_L(0); PG8_MMA(0, 1, At, B1); PG8_BAR;
            PG8_LDA(At, 1, 1); PG8_STAGE(PG8_SA(1, 0), a3, voffA);
            PG8_BAR; PG8_WAIT_L(0); PG8_MMA(1, 0, At, B0); PG8_BAR; PG8_SCHED;
            PG8_STAGE(PG8_SB(1, 1), b3 + hstep, voffB);
            PG8_WAIT_V(6); PG8_BAR; PG8_MMA(1, 1, At, B1); PG8_BAR;
        }
        PG8_STAMP();
        if constexpr (!Epi::AFTER_DRAIN) { E(acc, cur, wr, wc, fr, fq); S.done(cur); }
        PG8_STAMP();
        if (!has_next) break;
#pragma unroll
        for (int a = 0; a < 2; ++a)
#pragma unroll
            for (int b = 0; b < 2; ++b)
#pragma unroll
                for (int m = 0; m < 4; ++m)
#pragma unroll
                    for (int n = 0; n < 2; ++n) acc[a][b][m][n] = (f32x4){0.f, 0.f, 0.f, 0.f};
        cur = nxt; cA = nA; cB = nB; ++ui;
    }
    PG8_WAIT_V(0);
    if (wr == 0) PG8_BAR;
    PG8_BAR;
    if constexpr (Epi::AFTER_DRAIN) { E.fused(acc, cur, wr, wc, fr, fq, lds, wid, lane); S.done(cur); }
    PG8_STAMP();
    if (STAMP && wid == 0) { stamps[lane] = lane < nts ? (((unsigned long long)(unsigned)ts_hi << 32) | (unsigned)ts_lo) : 0ull;
        if (lane == 62) stamps[62] = rt_entry; if (lane == 63) stamps[63] = (unsigned long long)wall_clock64(); }
#undef PG8_STAMP
#undef PG8_SA
#undef PG8_SB
#undef PG8_STAGE
#undef PG8_LDA
#undef PG8_LDB
#undef PG8_MMA
#undef PG8_WAIT_V
#undef PG8_WAIT_L
#undef PG8_BAR
#undef PG8_SCHED
}
}


namespace cg = cooperative_groups;
using pg8::bf16_t; using pg8::bf16x8; using pg8::f32x4; using pg8::u32x4; using pg8::Unit;
#define LAS __attribute__((address_space(3)))
typedef short bf16x4 __attribute__((ext_vector_type(4)));
typedef unsigned u32x2 __attribute__((ext_vector_type(2)));

constexpr int NTOK = 8192, DM = 2048, TPR = 4096;
constexpr float EPSN = 1e-6f;
constexpr int MODW = 12288;
constexpr int LDS_BYTES = 131072 + 256;

struct Params {
    const float *x_prompt, *x_sample, *cache_k, *cache_v, *st_f, *st_b, *c, *c_ctx, *ada_w, *ada_b, *norm_mix_g, *norm_ffn_g;
    const float *even_w_in, *even_w_out, *attn_sink, *sgu_ln_g, *sgu_ln_b, *sgu_w, *sgu_b, *ret_w_in, *ret_w_out, *ret_gn_g, *ret_dec_f, *ret_dec_b;
    const float *ffn_w_gate, *ffn_w_up, *ffn_w_down, *final_g;
    float* out;
    bf16_t *wt_in0, *wt_out0, *wt_f1a, *wt_f1b, *wt_f2a, *wt_f2b, *wt_in1, *wt_out1;
    float* mod; float* stat; unsigned* bar; unsigned* qc;
    bf16_t* h;
    bf16_t *q0, *k0, *vt0, *u0, *vg0, *ck, *cvt, *ag;
    float *xa, *xb;
    bf16_t* act;
    bf16_t *q1, *k1, *sg1, *kt1, *vt1, *o1, *a2;
};
typedef const Params __attribute__((address_space(4))) * ParamsCP;


__device__ __forceinline__ unsigned pk2(float lo, float hi) { unsigned r; asm("v_cvt_pk_bf16_f32 %0, %1, %2" : "=v"(r) : "v"(lo), "v"(hi)); return r; }
__device__ __forceinline__ bf16_t f2bf(float f) { return (bf16_t)(pk2(f, 0.f) & 0xffffu); }
__device__ __forceinline__ float bflo(unsigned w) { return __uint_as_float(w << 16); }
__device__ __forceinline__ float bfhi(unsigned w) { return __uint_as_float(w & 0xffff0000u); }
__device__ __forceinline__ u32x2 pack4(f32x4 a) { u32x2 w; w.x = pk2(a[0], a[1]); w.y = pk2(a[2], a[3]); return w; }
__device__ __forceinline__ u32x4 pack8u(f32x4 a, f32x4 b) { u32x4 w; w.x = pk2(a[0], a[1]); w.y = pk2(a[2], a[3]); w.z = pk2(b[0], b[1]); w.w = pk2(b[2], b[3]); return w; }
__device__ __forceinline__ bf16x8 pack8(f32x4 a, f32x4 b) { return __builtin_bit_cast(bf16x8, pack8u(a, b)); }
__device__ __forceinline__ f32x4 unpack4(u32x2 w) { f32x4 r; r[0] = bflo(w.x); r[1] = bfhi(w.x); r[2] = bflo(w.y); r[3] = bfhi(w.y); return r; }
__device__ __forceinline__ bf16x8 cat44(bf16x4 a, bf16x4 b) { return __builtin_shufflevector(a, b, 0, 1, 2, 3, 4, 5, 6, 7); }
__device__ __forceinline__ f32x4 mfma16(bf16x8 a, bf16x8 b, f32x4 c) { return __builtin_amdgcn_mfma_f32_16x16x32_bf16(a, b, c, 0, 0, 0); }
__device__ __forceinline__ float siluf(float v) { return v / (1.0f + __expf(-v)); }
__device__ __forceinline__ float gelu_tanh(float v) { const float y = 0.7978845608028654f * (v + 0.044715f * v * v * v); return v / (1.0f + __expf(-2.0f * y)); }
__device__ __forceinline__ float wave_sum(float v) {
#pragma unroll
    for (int o = 32; o >= 1; o >>= 1) v += __shfl_xor(v, o);
    return v;
}

struct EpiInProj0 {
    static constexpr bool PERM = false, AFTER_DRAIN = false;
    bf16_t *q, *k, *vt, *u, *vg; float *outk, *outv, *stat;
    __device__ __forceinline__ void operator()(const f32x4 (&acc)[2][2][4][2], const Unit& un, int wr_, int wc_, int fr_, int fq_) const {
        int wr = wr_, wc = wc_, fr = fr_, fq = fq_; asm volatile("" : "+s"(wr), "+s"(wc), "+v"(fr), "+v"(fq));
        const int pn = un.pn;
        const int row0 = un.pm * 256 + wr * 64 + fr;
        const int cb = wc * 32 + 4 * fq;
        if (pn < 5) {
            const bool isq = pn < 4;
            const bool rope = un.pm >= 16;
            float inv[4];
#pragma unroll
            for (int j = 0; j < 4; ++j) inv[j] = __builtin_amdgcn_exp2f(-(float)(4 * fq + j) * 0.8304820237218406f);
#pragma unroll
            for (int ai = 0; ai < 2; ++ai)
#pragma unroll
                for (int m = 0; m < 4; ++m) {
                    const int row = row0 + ai * 128 + m * 16;
                    float cs[4], sn[4];
                    if (rope) {
                        const int pos = (row - TPR) & 1023;
                        const float t = (wc & 1) ? (float)(pos & 63) : (float)(pos >> 6);
#pragma unroll
                        for (int j = 0; j < 4; ++j) { const float a = t * inv[j]; cs[j] = __cosf(a); sn[j] = __sinf(a); }
                    } else {
#pragma unroll
                        for (int j = 0; j < 4; ++j) { cs[j] = 1.f; sn[j] = 0.f; }
                    }
#pragma unroll
                    for (int bj = 0; bj < 2; ++bj) {
                        const f32x4 x1 = acc[ai][bj][m][0], x2 = acc[ai][bj][m][1];
                        f32x4 o1, o2;
#pragma unroll
                        for (int j = 0; j < 4; ++j) { o1[j] = x1[j] * cs[j] - x2[j] * sn[j]; o2[j] = x2[j] * cs[j] + x1[j] * sn[j]; }
                        const int c = bj * 128 + cb;
                        if (isq) {
                            bf16_t* d = q + (size_t)row * 1024 + pn * 256 + c;
                            *(u32x2*)d = pack4(o1); *(u32x2*)(d + 16) = pack4(o2);
                        } else {
                            bf16_t* d = k + (size_t)row * 256 + c;
                            *(u32x2*)d = pack4(o1); *(u32x2*)(d + 16) = pack4(o2);
                            if (!rope) { float* ok = outk + (size_t)row * 256 + c; *(f32x4*)ok = x1; *(f32x4*)(ok + 16) = x2; }
                        }
                    }
                    __builtin_amdgcn_sched_barrier(0);
                }
        } else if (pn == 5) {
            const bool prm = un.pm < 16;
#pragma unroll
            for (int ai = 0; ai < 2; ++ai)
#pragma unroll
                for (int m = 0; m < 4; ++m) {
                    const int row = row0 + ai * 128 + m * 16;
#pragma unroll
                    for (int bj = 0; bj < 2; ++bj)
#pragma unroll
                        for (int n = 0; n < 2; ++n) {
                            const f32x4 v = acc[ai][bj][m][n];
                            const int c = bj * 128 + cb + n * 16;
                            if (prm) *(f32x4*)(outv + (size_t)row * 256 + c) = v;
#pragma unroll
                            for (int j = 0; j < 4; ++j) vt[(size_t)(c + j) * NTOK + row] = f2bf(v[j]);
                            __builtin_amdgcn_sched_barrier(0);
                        }
                }
        } else {
            const bool isvg = pn >= 10;
            bf16_t* dst = pn < 10 ? u + (pn - 6) * 256 : vg + (pn - 10) * 256;
#pragma unroll
            for (int ai = 0; ai < 2; ++ai)
#pragma unroll
                for (int m = 0; m < 4; ++m) {
                    const int row = row0 + ai * 128 + m * 16;
                    float ssum = 0.f, ssq = 0.f;
#pragma unroll
                    for (int bj = 0; bj < 2; ++bj)
#pragma unroll
                        for (int n = 0; n < 2; ++n) {
                            const f32x4 v = acc[ai][bj][m][n];
                            f32x4 o;
#pragma unroll
                            for (int j = 0; j < 4; ++j) { o[j] = gelu_tanh(v[j]); ssum += o[j]; ssq += o[j] * o[j]; }
                            *(u32x2*)(dst + (size_t)row * 1024 + bj * 128 + cb + n * 16) = pack4(o);
                        }
                    if (isvg) {
                        ssum += __shfl_xor(ssum, 16); ssum += __shfl_xor(ssum, 32); ssq += __shfl_xor(ssq, 16); ssq += __shfl_xor(ssq, 32);
                        if (fq == 0) { unsafeAtomicAdd(stat + 2 * row, ssum); unsafeAtomicAdd(stat + 2 * row + 1, ssq); }
                    }
                    __builtin_amdgcn_sched_barrier(0);
                }
        }
    }
};

struct EpiResid {
    static constexpr bool PERM = false, AFTER_DRAIN = false;
    const float *res_lo, *res_hi; const float* gate; float* out;
    __device__ __forceinline__ void operator()(const f32x4 (&acc)[2][2][4][2], const Unit& un, int wr_, int wc_, int fr_, int fq_) const {
        int wr = wr_, wc = wc_, fr = fr_, fq = fq_; asm volatile("" : "+s"(wr), "+s"(wc), "+v"(fr), "+v"(fq));
        const int cond = un.pm < 16 ? 0 : 1 + ((un.pm - 16) >> 2);
        const int row0 = un.pm * 256 + wr * 64 + fr, col0 = un.pn * 256 + wc * 32 + 4 * fq;
        const float* resb = un.pm < 16 ? res_lo : res_hi;
        f32x4 gv[2][2];
#pragma unroll
        for (int bj = 0; bj < 2; ++bj)
#pragma unroll
            for (int n = 0; n < 2; ++n) gv[bj][n] = *(const f32x4*)(gate + (size_t)cond * MODW + col0 + bj * 128 + n * 16);
#pragma unroll
        for (int ai = 0; ai < 2; ++ai)
#pragma unroll
            for (int m = 0; m < 4; ++m) {
                const size_t ro = (size_t)(row0 + ai * 128 + m * 16) * DM + col0;
#pragma unroll
                for (int bj = 0; bj < 2; ++bj)
#pragma unroll
                    for (int n = 0; n < 2; ++n) {
                        const f32x4 r = *(const f32x4*)(resb + ro + bj * 128 + n * 16);
                        *(f32x4*)(out + ro + bj * 128 + n * 16) = r + gv[bj][n] * acc[ai][bj][m][n];
                    }
            }
    }
};

struct EpiSwiGLU {
    static constexpr bool PERM = true, AFTER_DRAIN = false;
    bf16_t* act;
    __device__ __forceinline__ void operator()(const f32x4 (&acc)[2][2][4][2], const Unit& un, int wr_, int wc_, int fr_, int fq_) const {
        int wr = wr_, wc = wc_, fr = fr_, fq = fq_; asm volatile("" : "+s"(wr), "+s"(wc), "+v"(fr), "+v"(fq));
        const int row0 = un.pm * 256 + wr * 64 + fr, col0 = un.pn * 128 + wc * 32 + 8 * fq;
#pragma unroll
        for (int ai = 0; ai < 2; ++ai)
#pragma unroll
            for (int m = 0; m < 4; ++m) {
                f32x4 o[2];
#pragma unroll
                for (int n = 0; n < 2; ++n)
#pragma unroll
                    for (int j = 0; j < 4; ++j) o[n][j] = siluf(acc[ai][0][m][n][j]) * acc[ai][1][m][n][j];
                *(u32x4*)(act + (size_t)(row0 + ai * 128 + m * 16) * 5632 + col0) = pack8u(o[0], o[1]);
            }
    }
};

struct EpiRetIn {
    static constexpr bool PERM = true, AFTER_DRAIN = false;
    bf16_t *q1, *k1, *sg1, *kt1, *vt1;
    __device__ __forceinline__ void operator()(const f32x4 (&acc)[2][2][4][2], const Unit& un, int wr_, int wc_, int fr_, int fq_) const {
        int wr = wr_, wc = wc_, fr = fr_, fq = fq_; asm volatile("" : "+s"(wr), "+s"(wc), "+v"(fr), "+v"(fq));
        const int pn = un.pn;
        const int row0 = un.pm * 256 + wr * 64 + fr, cb = wc * 32 + 8 * fq;
#pragma unroll
        for (int ai = 0; ai < 2; ++ai)
#pragma unroll
            for (int m = 0; m < 4; ++m) {
                const int row = row0 + ai * 128 + m * 16;
#pragma unroll
                for (int bj = 0; bj < 2; ++bj) {
                    f32x4 v0 = acc[ai][bj][m][0], v1 = acc[ai][bj][m][1];
                    const int c = bj * 128 + cb;
                    if (pn < 8) {
                        *(u32x4*)(q1 + (size_t)row * 2048 + pn * 256 + c) = pack8u(v0, v1);
                    } else if (pn < 16) {
                        v0 *= 0.0625f; v1 *= 0.0625f;
                        const int cc = (pn - 8) * 256 + c;
                        *(u32x4*)(k1 + (size_t)row * 2048 + cc) = pack8u(v0, v1);
#pragma unroll
                        for (int j = 0; j < 4; ++j) { kt1[(size_t)(cc + j) * NTOK + row] = f2bf(v0[j]); kt1[(size_t)(cc + 4 + j) * NTOK + row] = f2bf(v1[j]); }
                    } else if (pn < 32) {
                        const int cc = (pn - 16) * 256 + c;
#pragma unroll
                        for (int j = 0; j < 4; ++j) { vt1[(size_t)(cc + j) * NTOK + row] = f2bf(v0[j]); vt1[(size_t)(cc + 4 + j) * NTOK + row] = f2bf(v1[j]); }
                    } else {
                        f32x4 s0, s1;
#pragma unroll
                        for (int j = 0; j < 4; ++j) { s0[j] = siluf(v0[j]); s1[j] = siluf(v1[j]); }
                        *(u32x4*)(sg1 + (size_t)row * 4096 + (pn - 32) * 256 + c) = pack8u(s0, s1);
                    }
                    __builtin_amdgcn_sched_barrier(0);
                }
            }
    }
};

template <class Epi>
__device__ __forceinline__ void run_gemm(LAS unsigned char* lds, const bf16_t* A, const bf16_t* Bt, int N, int K, const Epi& E) {
    pg8::Gemm g; g.A = A; g.Bt = Bt; g.M = NTOK; g.N = N; g.K = K;
    pg8::StaticOrder S; S.init(NTOK, N, (int)gridDim.x, (int)blockIdx.x);
    pg8::gemm_phase<Epi, pg8::StaticOrder, false>(lds, g, S, E, nullptr);
}

template <int MODE>
__device__ __forceinline__ void cvt_wt(const float* __restrict__ s0, const float* __restrict__ s1, int ld, bf16_t* __restrict__ dst, int K, int nrows, int tid) {
    const int nkb = K >> 5, nit = nkb * (nrows >> 9);
    for (int it = blockIdx.x; it < nit; it += gridDim.x) {
        const int kb = it % nkb, rb = it / nkb;
        const int r = rb * 512 + tid;
        const float* src; int col;
        if (MODE == 0) { src = s0; col = r; } else { src = ((r >> 7) & 1) ? s1 : s0; col = (r >> 8) * 128 + (r & 127); }
        const float* sp = src + (size_t)(kb * 32) * ld + col;
        float v[32];
#pragma unroll
        for (int i = 0; i < 32; ++i) v[i] = sp[(size_t)i * ld];
        u32x4* dp = (u32x4*)(dst + (size_t)r * K + kb * 32);
#pragma unroll
        for (int i = 0; i < 4; ++i) { u32x4 w; w.x = pk2(v[8 * i], v[8 * i + 1]); w.y = pk2(v[8 * i + 2], v[8 * i + 3]); w.z = pk2(v[8 * i + 4], v[8 * i + 5]); w.w = pk2(v[8 * i + 6], v[8 * i + 7]); dp[i] = w; }
    }
}

constexpr int CVQ_ITEMS = 1536 + 512 + 1408 + 704;
__device__ __forceinline__ void cvt_item(ParamsCP p, int item, int tid) {
    const float *s0, *s1; int ld, K, mode = 0, local; bf16_t* dst;
    if (item < 1536) { s0 = p->ret_w_in; s1 = s0; ld = 12288; dst = p->wt_in1; K = 2048; local = item; }
    else if (item < 2048) { s0 = p->ret_w_out; s1 = s0; ld = 2048; dst = p->wt_out1; K = 4096; local = item - 1536; }
    else if (item < 3456) { mode = 1; s0 = p->ffn_w_gate + (size_t)2048 * 5632; s1 = p->ffn_w_up + (size_t)2048 * 5632; ld = 5632; dst = p->wt_f1b; K = 2048; local = item - 2048; }
    else { s0 = p->ffn_w_down + (size_t)5632 * 2048; s1 = s0; ld = 2048; dst = p->wt_f2b; K = 5632; local = item - 3456; }
    const int nkb = K >> 5, kb = local % nkb, rb = local / nkb;
    const int r = rb * 512 + tid;
    const float* src = s0; int col = r;
    if (mode) { src = ((r >> 7) & 1) ? s1 : s0; col = (r >> 8) * 128 + (r & 127); }
    const float* sp = src + (size_t)(kb * 32) * ld + col;
    float v[32];
#pragma unroll
    for (int i = 0; i < 32; ++i) v[i] = sp[(size_t)i * ld];
    u32x4* dp = (u32x4*)(dst + (size_t)r * K + kb * 32);
#pragma unroll
    for (int i = 0; i < 4; ++i) { u32x4 w; w.x = pk2(v[8 * i], v[8 * i + 1]); w.y = pk2(v[8 * i + 2], v[8 * i + 3]); w.z = pk2(v[8 * i + 4], v[8 * i + 5]); w.w = pk2(v[8 * i + 6], v[8 * i + 7]); dp[i] = w; }
}
__device__ __forceinline__ void cvt_queue(ParamsCP p, LAS unsigned char* lds, int tid, int max_items) {
    LAS int* slot = (LAS int*)(lds + 64);
    for (int n = 0; n < max_items; ++n) {
        __syncthreads();
        if (tid == 0) *slot = (int)__hip_atomic_fetch_add(p->qc, 1u, __ATOMIC_RELAXED, __HIP_MEMORY_SCOPE_AGENT);
        __syncthreads();
        const int item = *slot;
        if (item >= CVQ_ITEMS) break;
        cvt_item(p, item, tid);
    }
}

__device__ __forceinline__ void phase0(ParamsCP p, LAS unsigned char* lds, int tid, bool do_ada) {
    LAS float* sc = (LAS float*)lds;
    for (int i = tid; i < 5 * 2048; i += 512) { const int cnd = i >> 11, k = i & 2047; const float v = cnd == 0 ? p->c_ctx[k] : p->c[(cnd - 1) * 2048 + k]; sc[i] = siluf(v); }
    __syncthreads();
    for (int it = blockIdx.x; do_ada && it < 2 * 24 * 16; it += gridDim.x) {
        const int kb = it & 15, nb = (it >> 4) % 24, li = it / (16 * 24);
        const int n = nb * 512 + tid;
        const float* w = p->ada_w + ((size_t)li * 2048 + kb * 128) * MODW + n;
        float a0 = 0.f, a1 = 0.f, a2 = 0.f, a3 = 0.f, a4 = 0.f;
#pragma unroll 4
        for (int k = 0; k < 128; k += 4) {
            const float w0 = w[(size_t)k * MODW], w1 = w[(size_t)(k + 1) * MODW], w2 = w[(size_t)(k + 2) * MODW], w3 = w[(size_t)(k + 3) * MODW];
            const int kk = kb * 128 + k;
            const f32x4 s0 = *(const LAS f32x4*)(sc + kk), s1 = *(const LAS f32x4*)(sc + 2048 + kk), s2 = *(const LAS f32x4*)(sc + 4096 + kk), s3 = *(const LAS f32x4*)(sc + 6144 + kk), s4 = *(const LAS f32x4*)(sc + 8192 + kk);
            a0 += s0[0] * w0 + s0[1] * w1 + s0[2] * w2 + s0[3] * w3;
            a1 += s1[0] * w0 + s1[1] * w1 + s1[2] * w2 + s1[3] * w3;
            a2 += s2[0] * w0 + s2[1] * w1 + s2[2] * w2 + s2[3] * w3;
            a3 += s3[0] * w0 + s3[1] * w1 + s3[2] * w2 + s3[3] * w3;
            a4 += s4[0] * w0 + s4[1] * w1 + s4[2] * w2 + s4[3] * w3;
        }
        if (kb == 0) { const float b = p->ada_b[li * MODW + n]; a0 += b; a1 += b; a2 += b; a3 += b; a4 += b; }
        float* m = p->mod + (size_t)li * 5 * MODW + n;
        unsafeAtomicAdd(m, a0); unsafeAtomicAdd(m + MODW, a1); unsafeAtomicAdd(m + 2 * MODW, a2); unsafeAtomicAdd(m + 3 * MODW, a3); unsafeAtomicAdd(m + 4 * MODW, a4);
    }
    for (int i = blockIdx.x * 512 + tid; i < 4 * 512 * 256 / 8; i += gridDim.x * 512) {
        const float* s = p->cache_k + (size_t)i * 8; const f32x4 a = *(const f32x4*)s, b = *(const f32x4*)(s + 4);
        *(u32x4*)(p->ck + (size_t)i * 8) = pack8u(a, b);
    }
    for (int i = blockIdx.x * 512 + tid; i < 4 * 64 * 256; i += gridDim.x * 512) {
        const int c = i & 255, mb = (i >> 8) & 63, b = i >> 14;
        float v[8];
#pragma unroll
        for (int j = 0; j < 8; ++j) v[j] = p->cache_v[((size_t)(b * 512 + mb * 8 + j)) * 256 + c];
        u32x4 w; w.x = pk2(v[0], v[1]); w.y = pk2(v[2], v[3]); w.z = pk2(v[4], v[5]); w.w = pk2(v[6], v[7]);
        *(u32x4*)(p->cvt + ((size_t)(b * 256 + c)) * 512 + mb * 8) = w;
    }
    cvt_wt<0>(p->even_w_in, nullptr, 3584, p->wt_in0, 2048, 3584, tid);
    cvt_wt<0>(p->even_w_out, nullptr, 2048, p->wt_out0, 2048, 2048, tid);
    cvt_wt<1>(p->ffn_w_gate, p->ffn_w_up, 5632, p->wt_f1a, 2048, 11264, tid);
    cvt_wt<0>(p->ffn_w_down, nullptr, 2048, p->wt_f2a, 5632, 2048, tid);
}

__device__ __forceinline__ void norm_phase(const float* xlo, const float* xhi, const float* g, const float* shift, const float* scale, bf16_t* h, int wid, int lane) {
#pragma unroll 2
    for (int row = blockIdx.x * 8 + wid; row < NTOK; row += gridDim.x * 8) {
        const float* xr = (row < TPR ? xlo : xhi) + (size_t)row * DM;
        const int cond = row < TPR ? 0 : 1 + ((row - TPR) >> 10);
        f32x4 v[8]; float ss = 0.f;
#pragma unroll
        for (int i = 0; i < 8; ++i) { v[i] = *(const f32x4*)(xr + i * 256 + lane * 4); ss += v[i][0] * v[i][0] + v[i][1] * v[i][1] + v[i][2] * v[i][2] + v[i][3] * v[i][3]; }
        ss = wave_sum(ss);
        const float rstd = rsqrtf(ss * (1.0f / DM) + EPSN);
#pragma unroll
        for (int i = 0; i < 8; ++i) {
            const int c = i * 256 + lane * 4;
            const f32x4 gg = *(const f32x4*)(g + c), sh = *(const f32x4*)(shift + (size_t)cond * MODW + c), sc = *(const f32x4*)(scale + (size_t)cond * MODW + c);
            const f32x4 o = v[i] * rstd * gg * (1.0f + sc) + sh;
            *(u32x2*)(h + (size_t)row * DM + c) = pack4(o);
        }
    }
}
__device__ __forceinline__ void final_norm_phase(const float* x, const float* g, float* out, int wid, int lane) {
#pragma unroll 2
    for (int row = blockIdx.x * 8 + wid; row < NTOK; row += gridDim.x * 8) {
        const float* xr = x + (size_t)row * DM;
        f32x4 v[8]; float ss = 0.f;
#pragma unroll
        for (int i = 0; i < 8; ++i) { v[i] = *(const f32x4*)(xr + i * 256 + lane * 4); ss += v[i][0] * v[i][0] + v[i][1] * v[i][1] + v[i][2] * v[i][2] + v[i][3] * v[i][3]; }
        ss = wave_sum(ss);
        const float rstd = rsqrtf(ss * (1.0f / DM) + EPSN);
#pragma unroll
        for (int i = 0; i < 8; ++i) { const int c = i * 256 + lane * 4; *(f32x4*)(out + (size_t)row * DM + c) = v[i] * rstd * *(const f32x4*)(g + c); }
    }
}

__device__ __forceinline__ void sgu_phase(ParamsCP p, LAS unsigned char* lds, int tid, int wid, int lane) {
    LAS bf16_t* vnT = (LAS bf16_t*)(lds + 1024);
    const int er = lane & 15, g4 = lane >> 4;
    for (int it = blockIdx.x; it < 512; it += gridDim.x) {
        const int chunk = it >> 3, g = it & 7, tok0 = chunk * 128;
        __syncthreads();
#pragma unroll
        for (int i2 = 0; i2 < 4; ++i2) {
            const int idx = tid + 512 * i2, q = idx >> 4, c8 = (idx & 15) * 8;
            const u32x4 raw = *(const u32x4*)(p->vg0 + (size_t)(tok0 + q) * 1024 + g * 128 + c8);
            const float mu = p->stat[2 * (tok0 + q)] * (1.0f / 1024.0f), rs = rsqrtf(p->stat[2 * (tok0 + q) + 1] * (1.0f / 1024.0f) - mu * mu + EPSN);
            const f32x4 g0 = *(const f32x4*)(p->sgu_ln_g + g * 128 + c8), g1 = *(const f32x4*)(p->sgu_ln_g + g * 128 + c8 + 4);
            const f32x4 b0 = *(const f32x4*)(p->sgu_ln_b + g * 128 + c8), b1 = *(const f32x4*)(p->sgu_ln_b + g * 128 + c8 + 4);
#pragma unroll
            for (int i = 0; i < 4; ++i) {
                const float x0 = (bflo(raw[i]) - mu) * rs, x1 = (bfhi(raw[i]) - mu) * rs;
                const float gg0 = (2 * i < 4) ? g0[(2 * i) & 3] : g1[(2 * i) & 3], gg1 = (2 * i + 1 < 4) ? g0[(2 * i + 1) & 3] : g1[(2 * i + 1) & 3];
                const float bb0 = (2 * i < 4) ? b0[(2 * i) & 3] : b1[(2 * i) & 3], bb1 = (2 * i + 1 < 4) ? b0[(2 * i + 1) & 3] : b1[(2 * i + 1) & 3];
                vnT[(c8 + 2 * i) * 136 + q] = f2bf(x0 * gg0 + bb0);
                vnT[(c8 + 2 * i + 1) * 136 + q] = f2bf(x1 * gg1 + bb1);
            }
        }
        __syncthreads();
        bf16x8 wf[4];
#pragma unroll
        for (int kk = 0; kk < 4; ++kk) { const float* wp = p->sgu_w + ((size_t)(g * 128 + 16 * wid + er)) * 128 + 32 * kk + g4 * 8; wf[kk] = pack8(*(const f32x4*)wp, *(const f32x4*)(wp + 4)); }
        const int tok = tok0 + 16 * wid + er; const float bs = p->sgu_b[g * 128 + 16 * wid + er];
#pragma unroll
        for (int cc = 0; cc < 8; ++cc) {
            f32x4 a = {0.f, 0.f, 0.f, 0.f};
#pragma unroll
            for (int kk = 0; kk < 4; ++kk) { const bf16x8 af = *(const LAS bf16x8*)(vnT + (16 * cc + er) * 136 + 32 * kk + g4 * 8); a = mfma16(af, wf[kk], a); }
            const int c = g * 128 + 16 * cc + g4 * 4;
            const f32x4 uf = unpack4(*(const u32x2*)(p->u0 + (size_t)tok * 1024 + c));
            *(u32x2*)(p->ag + (size_t)tok * 2048 + 1024 + c) = pack4(uf * (a + bs));
        }
    }
}

__device__ __forceinline__ void attn_phase(ParamsCP p, int wid, int lane) {
    const int er = lane & 15, g4 = lane >> 4;
    const float SC = 0.125f * 1.4426950408889634f;
    for (int sl = blockIdx.x * 4 + (wid & 3); sl < 1024; sl += gridDim.x * 4) {
        const bool latent = wid < 4;
        int b, kvh, qt;
        if (latent) { qt = sl & 63; kvh = (sl >> 6) & 3; b = sl >> 8; } else { qt = sl & 15; kvh = (sl >> 4) & 3; b = sl >> 6; }
        const int tokbase = latent ? TPR + b * 1024 : b * 256;
        const int L = latent ? 1024 : 256;
        const int q0 = qt * 16;
        const bf16_t* qp = p->q0 + (size_t)(tokbase + q0 + er) * 1024 + kvh * 256 + g4 * 8;
        bf16x8 qf[4][2]; float m[4], l[4]; f32x4 o[4][4];
#pragma unroll
        for (int g = 0; g < 4; ++g) {
            qf[g][0] = *(const bf16x8*)(qp + g * 64); qf[g][1] = *(const bf16x8*)(qp + g * 64 + 32);
            m[g] = p->attn_sink[kvh * 4 + g] * 1.4426950408889634f; l[g] = g4 == 0 ? 1.0f : 0.0f;
#pragma unroll
            for (int dd = 0; dd < 4; ++dd) o[g][dd] = (f32x4){0.f, 0.f, 0.f, 0.f};
        }
        const int qpos = q0 + er;
        int klo = 0, khi = L;
        if (latent) { klo = (q0 - 128 < 0 ? 0 : q0 - 128) & ~31; khi = (q0 + 16 + 128 + 31) & ~31; if (khi > L) khi = L; }
        const int nloc = (khi - klo) >> 5, ntl = nloc + (latent ? 16 : 0);
        bf16x8 kfn[2][2];
#define ATT_ADDR(TI) \
            const bool loc_ = (TI) < nloc; \
            const int kt_ = loc_ ? klo + (TI) * 32 : ((TI) - nloc) * 32; \
            const bf16_t* kbase_ = loc_ ? p->k0 + (size_t)(tokbase + kt_) * 256 + kvh * 64 : p->ck + (size_t)(b * 512 + kt_) * 256 + kvh * 64; \
            const bf16_t* vbase_ = loc_ ? p->vt0 + (size_t)(kvh * 64) * NTOK + tokbase + kt_ : p->cvt + (size_t)(b * 256 + kvh * 64) * 512 + kt_; \
            const int vstride_ = loc_ ? NTOK : 512;
#define ATT_LOADK(TI) do { ATT_ADDR(TI) (void)vbase_; (void)vstride_; \
            _Pragma("unroll") for (int t = 0; t < 2; ++t) { \
                const bf16_t* kp = kbase_ + (unsigned)((16 * t + er) * 256 + g4 * 8); \
                kfn[t][0] = *(const bf16x8*)kp; kfn[t][1] = *(const bf16x8*)(kp + 32); } \
        } while (0)
        ATT_LOADK(0);
#pragma unroll 1
        for (int ti = 0; ti < ntl; ++ti) {
            const bool loc = ti < nloc;
            const int kt = loc ? klo + ti * 32 : (ti - nloc) * 32;
            const bool mask = loc && latent;
            bf16x8 kf[2][2], vf[4];
#pragma unroll
            for (int t = 0; t < 2; ++t) { kf[t][0] = kfn[t][0]; kf[t][1] = kfn[t][1]; }
            { ATT_ADDR(ti) (void)kbase_;
#pragma unroll
              for (int dd = 0; dd < 4; ++dd) { const bf16_t* vp = vbase_ + (unsigned)((16 * dd + er) * vstride_ + g4 * 4); vf[dd] = cat44(*(const bf16x4*)vp, *(const bf16x4*)(vp + 16)); } }
            if (ti + 1 < ntl) ATT_LOADK(ti + 1);
            float pen[2][4];
#pragma unroll
            for (int t = 0; t < 2; ++t)
#pragma unroll
                for (int j = 0; j < 4; ++j) { const int d = qpos - (kt + 16 * t + g4 * 4 + j); pen[t][j] = (mask && (d > 128 || d < -128)) ? -INFINITY : 0.0f; }
#pragma unroll
            for (int g = 0; g < 4; ++g) {
                f32x4 s[2];
#pragma unroll
                for (int t = 0; t < 2; ++t) {
                    s[t] = mfma16(kf[t][0], qf[g][0], (f32x4){0.f, 0.f, 0.f, 0.f});
                    s[t] = mfma16(kf[t][1], qf[g][1], s[t]);
                }
                float mx = -INFINITY;
#pragma unroll
                for (int t = 0; t < 2; ++t)
#pragma unroll
                    for (int j = 0; j < 4; ++j) { const float v = s[t][j] * SC + pen[t][j]; s[t][j] = v; mx = fmaxf(mx, v); }
                mx = fmaxf(mx, __shfl_xor(mx, 16)); mx = fmaxf(mx, __shfl_xor(mx, 32));
                const float mnew = fmaxf(m[g], mx);
                const float alpha = __builtin_amdgcn_exp2f(m[g] - mnew);
                m[g] = mnew; float lg_ = l[g] * alpha;
#pragma unroll
                for (int dd = 0; dd < 4; ++dd) o[g][dd] *= alpha;
                f32x4 p0, p1;
#pragma unroll
                for (int j = 0; j < 4; ++j) { p0[j] = __builtin_amdgcn_exp2f(s[0][j] - mnew); p1[j] = __builtin_amdgcn_exp2f(s[1][j] - mnew); lg_ += p0[j] + p1[j]; }
                l[g] = lg_;
                const bf16x8 pf = pack8(p0, p1);
#pragma unroll
                for (int dd = 0; dd < 4; ++dd) o[g][dd] = mfma16(vf[dd], pf, o[g][dd]);
            }
        }
#pragma unroll
        for (int g = 0; g < 4; ++g) {
            float lt = l[g]; lt += __shfl_xor(lt, 16); lt += __shfl_xor(lt, 32);
            const float rl = 1.0f / lt;
            bf16_t* op = p->ag + (size_t)(tokbase + q0 + er) * 2048 + (kvh * 4 + g) * 64 + g4 * 4;
#pragma unroll
            for (int dd = 0; dd < 4; ++dd) *(u32x2*)(op + 16 * dd) = pack4(o[g][dd] * rl);
        }
    }
}

__device__ __forceinline__ float logsig(float x) { return -log1pf(__expf(-x)); }
__device__ __forceinline__ bf16x8 scale8(bf16x8 f, const float (&s)[8]) {
    const u32x4 w = __builtin_bit_cast(u32x4, f); u32x4 r;
#pragma unroll
    for (int i = 0; i < 4; ++i) r[i] = pk2(bflo(w[i]) * s[2 * i], bfhi(w[i]) * s[2 * i + 1]);
    return __builtin_bit_cast(bf16x8, r);
}

__device__ __forceinline__ void ret_item(ParamsCP p, LAS unsigned char* lds, int seq, int h, int es, int tid, int wid, int lane) {
    LAS bf16_t* Qs = (LAS bf16_t*)lds; LAS bf16_t* Ks = Qs + 64 * 264; LAS bf16_t* KTs = Ks + 64 * 264; LAS bf16_t* Ps = KTs + 256 * 72;
    const bool sample = seq < 4;
    const int tokbase = sample ? TPR + seq * 1024 : (seq - 4) * 256;
    const int NC = sample ? 16 : 4;
    const int er_ = lane & 15, g4_ = lane >> 4;
    const int e0 = h * 512 + es * 128 + wid * 16;
    const float lgf = logsig(p->ret_dec_f[h]), lgb = logsig(p->ret_dec_b[h]);
    f32x4 S[16];
#pragma unroll 1
    for (int dir = 0; dir < 2; ++dir) {
        const float lg = dir ? lgf : lgb;
        if (sample) {
            const float* st = (dir ? p->st_f : p->st_b) + ((size_t)(seq * 8 + h) * 256) * 512 + es * 128 + wid * 16 + er_;
#pragma unroll
            for (int t = 0; t < 16; ++t)
#pragma unroll
                for (int j = 0; j < 4; ++j) { S[t][j] = st[(size_t)(16 * t + g4_ * 4 + j) * 512]; if (j == 3) __builtin_amdgcn_sched_barrier(0); }
        } else {
#pragma unroll
            for (int t = 0; t < 16; ++t) S[t] = (f32x4){0.f, 0.f, 0.f, 0.f};
        }
        const float gch = __expf(lg * 64.0f);
        u32x4 rq[4], rk[4], rkt[4];
#define RET_LOAD(SIDX) do { \
            const int cc_ = dir ? (SIDX) : NC - 1 - (SIDX), tk_ = tokbase + cc_ * 64; \
            int tv_ = tid, e_ = er_, g_ = g4_; asm volatile("" : "+v"(tv_), "+v"(e_), "+v"(g_)); \
            const bf16_t* qb_ = p->q1 + (size_t)tk_ * 2048 + h * 256; \
            const bf16_t* kb_ = p->k1 + (size_t)tk_ * 2048 + h * 256; \
            const bf16_t* ktb_ = p->kt1 + (size_t)(h * 256) * NTOK + tk_; \
            _Pragma("unroll") for (int i2 = 0; i2 < 4; ++i2) { \
                const int idx = tv_ + 512 * i2; \
                { const int r = idx >> 5, c8 = (idx & 31) * 8; \
                  rq[i2] = *(const u32x4*)(qb_ + (unsigned)(r * 2048 + c8)); \
                  if (dir) rk[i2] = *(const u32x4*)(kb_ + (unsigned)(r * 2048 + c8)); } \
                { const int r = idx >> 3, c8 = (idx & 7) * 8; \
                  rkt[i2] = *(const u32x4*)(ktb_ + (unsigned)(r * NTOK + c8)); } \
            } \
        } while (0)
        RET_LOAD(0);
#pragma unroll 1
        for (int s = 0; s < NC; ++s) {
            const int cc = dir ? s : NC - 1 - s, tok0 = tokbase + cc * 64;
            int tidv = tid, er = er_, g4 = g4_; asm volatile("" : "+v"(tidv), "+v"(er), "+v"(g4));
            bf16_t* ob = p->o1 + (size_t)tok0 * 4096 + e0;
            __syncthreads();
#pragma unroll
            for (int i2 = 0; i2 < 4; ++i2) {
                const int idx = tidv + 512 * i2;
                { const int r = idx >> 5, c8 = (idx & 31) * 8;
                  *(LAS u32x4*)(Qs + r * 264 + c8) = rq[i2];
                  if (dir) *(LAS u32x4*)(Ks + r * 264 + c8) = rk[i2]; }
                { const int r = idx >> 3, c8 = (idx & 7) * 8;
                  *(LAS u32x4*)(KTs + r * 72 + c8) = rkt[i2]; }
            }
            bf16x8 vf[2]; u32x2 obc[4];
            { const bf16_t* vtb = p->vt1 + (size_t)e0 * NTOK + tok0;
#pragma unroll
              for (int kk = 0; kk < 2; ++kk) vf[kk] = *(const bf16x8*)(vtb + (unsigned)(er * NTOK + 32 * kk + g4 * 8));
              if (dir) {
#pragma unroll
                  for (int is = 0; is < 4; ++is) obc[is] = *(const u32x2*)(ob + (unsigned)((16 * is + er) * 4096 + g4 * 4));
              } }
            asm volatile("s_waitcnt lgkmcnt(0)" ::: "memory"); __builtin_amdgcn_s_barrier(); asm volatile("" ::: "memory");
            if (s + 1 < NC) RET_LOAD(s + 1);
            if (dir) {
#pragma unroll
                for (int pi2 = 0; pi2 < 2; ++pi2) {
                    const int pi = 2 * wid + pi2, js = pi >> 2, is = pi & 3;
                    f32x4 a = {0.f, 0.f, 0.f, 0.f};
#pragma unroll
                    for (int hb = 0; hb < 2; ++hb) {
                        bf16x8 kf[4], qf[4];
#pragma unroll
                        for (int u = 0; u < 4; ++u) {
                            kf[u] = *(const LAS bf16x8*)(Ks + (16 * js + er) * 264 + 32 * (4 * hb + u) + g4 * 8);
                            qf[u] = *(const LAS bf16x8*)(Qs + (16 * is + er) * 264 + 32 * (4 * hb + u) + g4 * 8);
                        }
                        asm volatile("" ::: "memory");
#pragma unroll
                        for (int u = 0; u < 4; ++u) a = mfma16(kf[u], qf[u], a);
                        __builtin_amdgcn_sched_group_barrier(0x100, 8, 0); __builtin_amdgcn_sched_group_barrier(0x008, 4, 0);
                    }
                    const int i = 16 * is + er;
#pragma unroll
                    for (int j4 = 0; j4 < 4; ++j4) {
                        const int j = 16 * js + g4 * 4 + j4, dd = i - j;
                        const float dv = dd > 0 ? __expf(lgf * (float)dd) : (dd < 0 ? __expf(lgb * (float)(-dd)) : 2.0f);
                        a[j4] *= dv;
                    }
                    *(LAS u32x2*)(Ps + i * 72 + 16 * js + g4 * 4) = pack4(a);
                }
                asm volatile("s_waitcnt lgkmcnt(0)" ::: "memory"); __builtin_amdgcn_s_barrier(); asm volatile("" ::: "memory");
            }
            f32x4 a2[4];
#pragma unroll
            for (int is = 0; is < 4; ++is) a2[is] = (f32x4){0.f, 0.f, 0.f, 0.f};
#pragma unroll
            for (int s8 = 0; s8 < 8; ++s8) {
                bf16x8 qf[4];
#pragma unroll
                for (int is = 0; is < 4; ++is) {
                    const LAS bf16_t* qp = Qs + (16 * is + er) * 264 + 32 * s8 + g4 * 4;
                    qf[is] = cat44(*(const LAS bf16x4*)qp, *(const LAS bf16x4*)(qp + 16));
                }
                const bf16x8 sf = pack8(S[2 * s8], S[2 * s8 + 1]);
#pragma unroll
                for (int is = 0; is < 4; ++is) a2[is] = mfma16(sf, qf[is], a2[is]);
                __builtin_amdgcn_sched_group_barrier(0x100, 4, 0); __builtin_amdgcn_sched_group_barrier(0x008, 4, 0);
            }
#pragma unroll
            for (int ip = 0; ip < 2; ++ip) {
                bf16x8 pfr[2][2];
                if (dir) {
#pragma unroll
                    for (int u = 0; u < 2; ++u)
#pragma unroll
                        for (int kk = 0; kk < 2; ++kk) pfr[u][kk] = *(const LAS bf16x8*)(Ps + (16 * (2 * ip + u) + er) * 72 + 32 * kk + g4 * 8);
                }
#pragma unroll
                for (int u = 0; u < 2; ++u) {
                    const int is = 2 * ip + u;
                    f32x4 o = a2[is] * __expf(lg * (float)(dir ? 16 * is + er + 1 : 64 - 16 * is - er));
                    bf16_t* op = ob + (unsigned)((16 * is + er) * 4096 + g4 * 4);
                    if (dir) {
                        f32x4 a1 = {0.f, 0.f, 0.f, 0.f};
#pragma unroll
                        for (int kk = 0; kk < 2; ++kk) a1 = mfma16(vf[kk], pfr[u][kk], a1);
                        o += a1; o += unpack4(obc[is]);
                    }
                    *(u32x2*)op = pack4(o);
                }
            }
            bf16x8 vs[2];
#pragma unroll
            for (int kk = 0; kk < 2; ++kk) {
                float fu[8];
#pragma unroll
                for (int i = 0; i < 8; ++i) { const int j = 32 * kk + g4 * 8 + i; fu[i] = __expf(lg * (float)(dir ? 63 - j : j)); }
                vs[kk] = scale8(vf[kk], fu);
            }

#pragma unroll
            for (int tg = 0; tg < 8; ++tg) {
                bf16x8 af[2][2];
#pragma unroll
                for (int u = 0; u < 2; ++u)
#pragma unroll
                    for (int kk = 0; kk < 2; ++kk) af[u][kk] = *(const LAS bf16x8*)(KTs + (16 * (2 * tg + u) + er) * 72 + 32 * kk + g4 * 8);
#pragma unroll
                for (int u = 0; u < 2; ++u) {
                    S[2 * tg + u] *= gch;
#pragma unroll
                    for (int kk = 0; kk < 2; ++kk) S[2 * tg + u] = mfma16(af[u][kk], vs[kk], S[2 * tg + u]);
                }
                __builtin_amdgcn_sched_group_barrier(0x100, 4, 0); __builtin_amdgcn_sched_group_barrier(0x008, 4, 0);
            }
        }
        if (!sample) {
            float* so = p->out + (dir ? (size_t)18874368 : (size_t)35651584) + ((size_t)((seq - 4) * 8 + h) * 256) * 512 + es * 128 + wid * 16 + er_;
#pragma unroll
            for (int t = 0; t < 16; ++t)
#pragma unroll
                for (int j = 0; j < 4; ++j) { so[(size_t)(16 * t + g4_ * 4 + j) * 512] = S[t][j]; if (j == 3) __builtin_amdgcn_sched_barrier(0); }
        }
    }
}

__device__ __forceinline__ void ret_phase(ParamsCP p, LAS unsigned char* lds, int tid, int wid, int lane) {
    for (int slot = blockIdx.x; slot < 256; slot += gridDim.x) {
        if (slot < 128) { ret_item(p, lds, slot >> 5, (slot >> 2) & 7, slot & 3, tid, wid, lane); }
        else {
#pragma unroll 1
            for (int k = 0; k < 4; ++k) { const int j = (slot - 128) * 4 + k; ret_item(p, lds, 4 + (j >> 5), (j >> 2) & 7, j & 3, tid, wid, lane); }
        }
    }
}

__device__ __forceinline__ void gn_phase(ParamsCP p, int wid, int lane) {
#pragma unroll 4
    for (int pr = blockIdx.x * 8 + wid; pr < NTOK * 8; pr += gridDim.x * 8) {
        const int tok = pr >> 3, h = pr & 7;
        const size_t base = (size_t)tok * 4096 + h * 512 + lane * 8;
        const u32x4 raw = *(const u32x4*)(p->o1 + base);
        float x[8]; float s = 0.f, ss = 0.f;
#pragma unroll
        for (int i = 0; i < 4; ++i) { x[2 * i] = bflo(raw[i]); x[2 * i + 1] = bfhi(raw[i]); s += x[2 * i] + x[2 * i + 1]; ss += x[2 * i] * x[2 * i] + x[2 * i + 1] * x[2 * i + 1]; }
        s = wave_sum(s); ss = wave_sum(ss);
        const float mu = s * (1.0f / 512.0f), var = ss * (1.0f / 512.0f) - mu * mu, rs = rsqrtf(var + EPSN);
        const f32x4 g0 = *(const f32x4*)(p->ret_gn_g + h * 512 + lane * 8), g1 = *(const f32x4*)(p->ret_gn_g + h * 512 + lane * 8 + 4);
        const u32x4 sg = *(const u32x4*)(p->sg1 + base);
        f32x4 o0, o1;
#pragma unroll
        for (int i = 0; i < 2; ++i) {
            o0[2 * i] = (x[2 * i] - mu) * rs * g0[2 * i] * bflo(sg[i]); o0[2 * i + 1] = (x[2 * i + 1] - mu) * rs * g0[2 * i + 1] * bfhi(sg[i]);
            o1[2 * i] = (x[4 + 2 * i] - mu) * rs * g1[2 * i] * bflo(sg[2 + i]); o1[2 * i + 1] = (x[4 + 2 * i + 1] - mu) * rs * g1[2 * i + 1] * bfhi(sg[2 + i]);
        }
        *(u32x4*)(p->a2 + base) = pack8u(o0, o1);
    }
}

#define XB_TMO      128
#define XB_XCNT(j)  (256  + 64 * (j))
#define XB_XSUB(j)  (1280 + 64 * (j))
#define XB_XGEN(j)  (2304 + 64 * (j))
#define XB_TOP      3328
#define XB_TOPGEN   3392
#define XCD_BAR_WORDS 3456
#define XB_SPIN_CAP (1u << 18)

__device__ __forceinline__ unsigned xb_ld(unsigned* p)              { return __hip_atomic_load(p, __ATOMIC_RELAXED, __HIP_MEMORY_SCOPE_AGENT); }
__device__ __forceinline__ unsigned xb_add(unsigned* p, unsigned v) { return __hip_atomic_fetch_add(p, v, __ATOMIC_RELAXED, __HIP_MEMORY_SCOPE_AGENT); }
__device__ __forceinline__ unsigned xb_xcc_id() { return (unsigned)__builtin_amdgcn_s_getreg((3 << 11) | 20) & 0xFu; }
#define XB_SPIN(cond, bar) do { unsigned _sp = 0; while (cond) { __builtin_amdgcn_s_sleep(1); \
    if ((++_sp & 255u) == 0u) { if (xb_ld(&(bar)[XB_TMO])) break; if (_sp > XB_SPIN_CAP) { atomicAdd(&(bar)[XB_TMO], 1u); break; } } } } while (0)

struct XcdBarrier {
    unsigned* bar; unsigned x;
    volatile LAS unsigned* st;
};

__device__ __forceinline__ XcdBarrier xcd_barrier_post(unsigned* bar, volatile LAS unsigned* st) {
    XcdBarrier b; b.bar = bar; b.x = xb_xcc_id(); b.st = st;
    if (threadIdx.x == 0) (void)xb_add(&bar[XB_XCNT(b.x)], 1u);
    return b;
}
__device__ __forceinline__ void xcd_barrier_complete(unsigned* bar, unsigned x, unsigned& nloc, unsigned& nx) {
    const unsigned G = gridDim.x * gridDim.y * gridDim.z;
    unsigned sum, cnt, mine, sp = 0u;
    for (;;) {
        sum = 0u; cnt = 0u; mine = 0u;
#pragma unroll
        for (unsigned j = 0; j < 16; ++j) { const unsigned c = xb_ld(&bar[XB_XCNT(j)]); sum += c; cnt += (c > 0u) ? 1u : 0u; mine = (j == x) ? c : mine; }
        if (sum == G) break;
        __builtin_amdgcn_s_sleep(1);
        if ((++sp & 255u) == 0u) { if (xb_ld(&bar[XB_TMO])) break; if (sp > XB_SPIN_CAP) { atomicAdd(&bar[XB_TMO], 1u); break; } }
    }
    nloc = mine > 0u ? mine : 1u; nx = cnt > 0u ? cnt : 1u;
}

__device__ __forceinline__ void xcd_barrier(const XcdBarrier& b) {
    asm volatile("s_waitcnt vmcnt(0)" ::: "memory");
    __syncthreads();
    if (threadIdx.x == 0) {
        unsigned* bar = b.bar;
        __builtin_amdgcn_s_waitcnt(0);
        unsigned nloc = b.st[0], nx = b.st[1];
        if (nloc == 0u) { xcd_barrier_complete(bar, b.x, nloc, nx); b.st[0] = nloc; b.st[1] = nx; }
        const unsigned old = xb_add(&bar[XB_XSUB(b.x)], 1u);
        const unsigned gen = old / nloc;
        if (old + 1u == (gen + 1u) * nloc) {
            __builtin_amdgcn_fence(__ATOMIC_RELEASE, "agent");
            asm volatile("s_waitcnt vmcnt(0)" ::: "memory");
            const unsigned og = xb_add(&bar[XB_TOP], 1u);
            const unsigned tg = og / nx;
            if (og + 1u == (tg + 1u) * nx) xb_add(&bar[XB_TOPGEN], 1u);
            else XB_SPIN(xb_ld(&bar[XB_TOPGEN]) == tg, bar);
            __builtin_amdgcn_fence(__ATOMIC_ACQUIRE, "agent");
            xb_add(&bar[XB_XGEN(b.x)], 1u);
            asm volatile("s_waitcnt vmcnt(0)" ::: "memory");
        } else {
            XB_SPIN(xb_ld(&bar[XB_XGEN(b.x)]) == gen, bar);
            __builtin_amdgcn_fence(__ATOMIC_ACQUIRE, "agent");
            asm volatile("s_waitcnt vmcnt(0)" ::: "memory");
        }
    }
    __syncthreads();
}

constexpr int NPHASE = 17;
__global__ void __launch_bounds__(512, 2) fwd_megakernel(Params p_unused, int ph_lo, int ph_hi) {
    extern __shared__ __attribute__((aligned(16))) unsigned char shm[];
    LAS unsigned char* lds = (LAS unsigned char*)shm;
    cg::grid_group grid = cg::this_grid();
    const int tid0 = threadIdx.x;
    volatile LAS unsigned* xst = (volatile LAS unsigned*)(lds + 131072);
    if (tid0 < 4) xst[tid0] = 0u;
    __syncthreads();
    { ParamsCP p0 = (ParamsCP)__builtin_amdgcn_kernarg_segment_ptr(); (void)xcd_barrier_post(p0->bar, xst); }
    if (ph_hi < 0) grid.sync();
#pragma unroll 1
    for (int ph = ph_lo; ph < ph_hi; ++ph) {
        if (ph > ph_lo) {
            ParamsCP pb = (ParamsCP)__builtin_amdgcn_kernarg_segment_ptr(); asm volatile("" : "+s"(pb));
            XcdBarrier xb; xb.bar = pb->bar; xb.x = xb_xcc_id(); xb.st = (volatile LAS unsigned*)(lds + 131072);
            xcd_barrier(xb);
#if defined(PROBE_DOUBLE_SYNC)
            xcd_barrier(xb);
#endif
        }
        int kind, L = 0;
        if (ph == 0) kind = 0;
        else if (ph == 16) kind = 11;
        else if (ph <= 7) { L = 0; const int k = ph - 1; kind = k == 0 ? 1 : k == 1 ? 2 : k == 2 ? 3 : k == 3 ? 4 : k == 4 ? 5 : k == 5 ? 6 : 7; }
        else { L = 1; const int k = ph - 8; kind = k == 0 ? 1 : k == 1 ? 8 : k == 2 ? 9 : k == 3 ? 10 : k == 4 ? 4 : k == 5 ? 5 : k == 6 ? 6 : 7; }
#ifndef PH_MASK
#define PH_MASK 0xfff
#endif
        if (!((PH_MASK >> kind) & 1)) continue;
#if defined(PROBE_REP_NONGEMM)
        const int nrep = ((PROBE_REP_NONGEMM >> kind) & 1) ? 2 : 1;
#else
        const int nrep = 1;
#endif
#pragma unroll 1
        for (int rep = 0; rep < nrep; ++rep) {
        if (rep) __syncthreads();
        int tid = tid0; asm volatile("" : "+v"(tid));
        ParamsCP p = (ParamsCP)__builtin_amdgcn_kernarg_segment_ptr(); asm volatile("" : "+s"(p));
        const int wid = __builtin_amdgcn_readfirstlane(tid >> 6), lane = tid & 63;
        const float* modL = p->mod + (size_t)L * 5 * MODW;
        switch (kind) {
        case 0: phase0(p, lds, tid, rep == 0); break;
        case 1: {
            const float* xlo = L == 0 ? p->x_prompt : p->xb; const float* xhi = L == 0 ? p->x_sample - (size_t)TPR * DM : p->xb;
            if (L == 1) cvt_queue(p, lds, tid, 1 << 30);
            norm_phase(xlo, xhi, p->norm_mix_g + L * DM, modL, modL + 2048, p->h, wid, lane);
        } break;
        case 2: { EpiInProj0 E; E.q = p->q0; E.k = p->k0; E.vt = p->vt0; E.u = p->u0; E.vg = p->vg0; E.outk = p->out + 16777216; E.outv = p->out + 17825792; E.stat = p->stat;
                  run_gemm(lds, p->h, p->wt_in0, 3584, 2048, E);
                  if (blockIdx.x >= 192) cvt_queue(p, lds, tid, 9); } break;
        case 3: sgu_phase(p, lds, tid, wid, lane); attn_phase(p, wid, lane); break;
        case 4: case 7: {
            EpiResid E; const bf16_t *A, *Bt; int K;
            if (kind == 4) {
                if (L == 0) { A = p->ag; Bt = p->wt_out0; K = 2048; E.res_lo = p->x_prompt; E.res_hi = p->x_sample - (size_t)TPR * DM; }
                else { A = p->a2; Bt = p->wt_out1; K = 4096; E.res_lo = p->xb; E.res_hi = p->xb; }
                E.gate = modL + 4096; E.out = p->xa;
            } else { A = p->act; Bt = L == 0 ? p->wt_f2a : p->wt_f2b; K = 5632; E.res_lo = p->xa; E.res_hi = p->xa; E.gate = modL + 10240; E.out = p->xb; }
            run_gemm(lds, A, Bt, 2048, K, E);
        } break;
        case 5: norm_phase(p->xa, p->xa, p->norm_ffn_g + L * DM, modL + 6144, modL + 8192, p->h, wid, lane); break;
        case 6: { EpiSwiGLU E; E.act = p->act; run_gemm(lds, p->h, L == 0 ? p->wt_f1a : p->wt_f1b, 11264, 2048, E);
                  if (L == 0 && blockIdx.x >= 128) cvt_queue(p, lds, tid, 11); } break;
        case 8: { EpiRetIn E; E.q1 = p->q1; E.k1 = p->k1; E.sg1 = p->sg1; E.kt1 = p->kt1; E.vt1 = p->vt1; run_gemm(lds, p->h, p->wt_in1, 12288, 2048, E); } break;
        case 9: ret_phase(p, lds, tid, wid, lane); break;
        case 10: gn_phase(p, wid, lane); break;
        default: final_norm_phase(p->xb, p->final_g, p->out, wid, lane); break;
        }
        }
    }
}

extern "C" void kernel_launch(void* const* d_in, const int* in_sizes, int n_in, void* d_out, int out_size, void* d_ws, size_t ws_size, hipStream_t stream) {
    (void)in_sizes; (void)n_in; (void)out_size; (void)ws_size;
    static int grid_blocks = 0;
    if (!grid_blocks) {
        hipFuncSetAttribute((const void*)fwd_megakernel, hipFuncAttributeMaxDynamicSharedMemorySize, LDS_BYTES);
        int dev = 0, cus = 0, per_cu = 0;
        hipGetDevice(&dev);
        hipDeviceGetAttribute(&cus, hipDeviceAttributeMultiprocessorCount, dev);
        hipOccupancyMaxActiveBlocksPerMultiprocessor(&per_cu, fwd_megakernel, 512, LDS_BYTES);
        if (per_cu < 1) per_cu = 1;
        if (per_cu > 1) per_cu = 1;
        grid_blocks = cus * per_cu;
    }
    Params hp;
    memset(&hp, 0, sizeof(hp));
    const float* const* in = (const float* const*)d_in;
    hp.x_prompt = in[0]; hp.x_sample = in[1]; hp.cache_k = in[2]; hp.cache_v = in[3]; hp.st_f = in[4]; hp.st_b = in[5]; hp.c = in[6]; hp.c_ctx = in[7];
    hp.ada_w = in[8]; hp.ada_b = in[9]; hp.norm_mix_g = in[10]; hp.norm_ffn_g = in[11]; hp.even_w_in = in[12]; hp.even_w_out = in[13]; hp.attn_sink = in[14];
    hp.sgu_ln_g = in[15]; hp.sgu_ln_b = in[16]; hp.sgu_w = in[17]; hp.sgu_b = in[18]; hp.ret_w_in = in[19]; hp.ret_w_out = in[20]; hp.ret_gn_g = in[21];
    hp.ret_dec_f = in[22]; hp.ret_dec_b = in[23]; hp.ffn_w_gate = in[24]; hp.ffn_w_up = in[25]; hp.ffn_w_down = in[26]; hp.final_g = in[27];
    hp.out = (float*)d_out;
    unsigned char* w = (unsigned char*)d_ws; size_t off = 0;
    auto take = [&](size_t bytes) { unsigned char* r = w + off; off += (bytes + 255) & ~(size_t)255; return r; };
    hp.wt_in0 = (bf16_t*)take((size_t)3584 * 2048 * 2); hp.wt_out0 = (bf16_t*)take((size_t)2048 * 2048 * 2);
    hp.wt_f1a = (bf16_t*)take((size_t)11264 * 2048 * 2); hp.wt_f1b = (bf16_t*)take((size_t)11264 * 2048 * 2);
    hp.wt_f2a = (bf16_t*)take((size_t)2048 * 5632 * 2); hp.wt_f2b = (bf16_t*)take((size_t)2048 * 5632 * 2);
    hp.wt_in1 = (bf16_t*)take((size_t)12288 * 2048 * 2); hp.wt_out1 = (bf16_t*)take((size_t)2048 * 4096 * 2);
    hp.mod = (float*)take((size_t)2 * 5 * MODW * 4); hp.stat = (float*)take((size_t)NTOK * 2 * 4); hp.bar = (unsigned*)take((size_t)XCD_BAR_WORDS * 4); hp.qc = (unsigned*)take(256);
    hp.h = (bf16_t*)take((size_t)NTOK * DM * 2);
    hp.xa = (float*)take((size_t)NTOK * DM * 4); hp.xb = (float*)take((size_t)NTOK * DM * 4);
    hp.act = (bf16_t*)take((size_t)NTOK * 5632 * 2); hp.a2 = hp.act;
    hp.o1 = (bf16_t*)take((size_t)NTOK * 4096 * 2);
    unsigned char* ra = w + off; const size_t ra_off = off;
    hp.q1 = (bf16_t*)take((size_t)NTOK * 2048 * 2); hp.k1 = (bf16_t*)take((size_t)NTOK * 2048 * 2); hp.sg1 = (bf16_t*)take((size_t)NTOK * 4096 * 2);
    hp.kt1 = (bf16_t*)take((size_t)2048 * NTOK * 2); hp.vt1 = (bf16_t*)take((size_t)4096 * NTOK * 2);
    off = ra_off; (void)ra;
    hp.q0 = (bf16_t*)take((size_t)NTOK * 1024 * 2); hp.k0 = (bf16_t*)take((size_t)NTOK * 256 * 2); hp.vt0 = (bf16_t*)take((size_t)256 * NTOK * 2);
    hp.u0 = (bf16_t*)take((size_t)NTOK * 1024 * 2); hp.vg0 = (bf16_t*)take((size_t)NTOK * 1024 * 2);
    hp.ck = (bf16_t*)take((size_t)4 * 512 * 256 * 2); hp.cvt = (bf16_t*)take((size_t)4 * 256 * 512 * 2); hp.ag = (bf16_t*)take((size_t)NTOK * 2048 * 2);
    hipMemsetAsync(hp.mod, 0, (size_t)((unsigned char*)hp.qc - (unsigned char*)hp.mod) + 256, stream);
#if defined(MK_MULTI)
    for (int ph = 0; ph < NPHASE; ++ph) hipLaunchKernelGGL(fwd_megakernel, dim3(grid_blocks), dim3(512), LDS_BYTES, stream, hp, ph, ph + 1);
#else
    int lo = 0, hi = NPHASE;
    void* args[] = {&hp, &lo, &hi};
    hipError_t e = hipLaunchCooperativeKernel((void*)fwd_megakernel, dim3(grid_blocks), dim3(512), args, LDS_BYTES, stream);
    if (e != hipSuccess) fprintf(stderr, "cooperative launch failed: %s (grid %d)\n", hipGetErrorString(e), grid_blocks);
#endif
}
```
